# Optimizing an MI355X kernel written in HIP

```python
import jax, jax.numpy as jnp
from jax import lax
import numpy as np

D_MODEL = 2048
BATCH = 4
SEQ = 4096
DEPTH = 1

HEAD_DIM = 64
N_FOX_HEADS = D_MODEL // (2 * HEAD_DIM)
N_SWA_HEADS = D_MODEL // (2 * HEAD_DIM)
N_SWA_KV_HEADS = N_SWA_HEADS // 4
SWA_GROUP = N_SWA_HEADS // N_SWA_KV_HEADS
MIX_WIDTH = (N_FOX_HEADS + N_SWA_HEADS) * HEAD_DIM
WINDOW = 128
Q_BLOCK = 128
N_MEM = 256
N_CROSS_HEADS = 4
CROSS_HEAD_DIM = D_MODEL // 16
N_EXPERTS = 32
TOP_K = 4
D_EXPERT = D_MODEL
SWIGLU_ALPHA = 1.702
SWIGLU_LIMIT = 7.0
EXPERT_BLOCK = 256
RMS_EPS = 1e-5
FOX_W = N_FOX_HEADS * HEAD_DIM
SWA_Q_W = N_SWA_HEADS * HEAD_DIM
SWA_KV_W = N_SWA_KV_HEADS * HEAD_DIM
IN_COLS = 3 * FOX_W + N_FOX_HEADS + SWA_Q_W + 2 * SWA_KV_W
CROSS_W = N_CROSS_HEADS * CROSS_HEAD_DIM

kernel_name = "hybrid_fox_swa_sink_moe_layer"


def rmsnorm(x, g):
    xf = x.astype(jnp.float32)
    y = xf * lax.rsqrt(jnp.mean(xf * xf, axis=-1, keepdims=True) + RMS_EPS)
    return (y * g.astype(jnp.float32)).astype(x.dtype)


def alibi_slopes(n):
    start = 2.0 ** (-8.0 / n)
    return np.array([start ** (i + 1) for i in range(n)], dtype=np.float32)


def forgetting_attention(q, k, v, log_f):
    B, S, H, d = q.shape
    nb = S // Q_BLOCK
    c = jnp.cumsum(log_f.astype(jnp.float32), axis=1)
    c_keys = c.transpose(0, 2, 1)
    kpos = jnp.arange(S)
    qb = q.reshape(B, nb, Q_BLOCK, H, d).transpose(1, 0, 2, 3, 4)
    cb = c.reshape(B, nb, Q_BLOCK, H).transpose(1, 0, 3, 2)
    scale = d ** -0.5

    def one_block(args):
        qi, ci, i = args
        s = jnp.einsum('bqhd,bkhd->bhqk', qi, k).astype(jnp.float32) * scale
        s = s + ci[..., None] - c_keys[:, :, None, :]
        qpos = i * Q_BLOCK + jnp.arange(Q_BLOCK)
        s = jnp.where(kpos[None, :] <= qpos[:, None], s, -jnp.inf)
        p = jax.nn.softmax(s, axis=-1).astype(v.dtype)
        return jnp.einsum('bhqk,bkhd->bqhd', p, v)

    out = lax.map(one_block, (qb, cb, jnp.arange(nb)))
    return out.transpose(1, 0, 2, 3, 4).reshape(B, S, H * d)


def sliding_window_sink_attention(q, k, v, sinks):
    B, S, Hkv, G, d = q.shape
    nb = S // WINDOW
    qb = q.reshape(B, nb, WINDOW, Hkv, G, d)

    def band(t):
        tb = t.reshape(B, nb, WINDOW, Hkv, d)
        prev = jnp.concatenate([jnp.zeros_like(tb[:, :1]), tb[:, :-1]], axis=1)
        return jnp.concatenate([prev, tb], axis=2)

    kb, vb = band(k), band(v)
    s = jnp.einsum('bnqhgd,bnkhd->bnhgqk', qb, kb).astype(jnp.float32) * (d ** -0.5)
    qi = jnp.arange(WINDOW)[:, None]
    kj = jnp.arange(2 * WINDOW)[None, :]
    rel = qi - kj + WINDOW
    kabs = jnp.arange(nb)[:, None] * WINDOW - WINDOW + kj
    valid = ((rel >= 0) & (rel < WINDOW))[None] & (kabs >= 0)[:, None, :]
    slopes = jnp.asarray(alibi_slopes(Hkv * G)).reshape(Hkv, G)
    s = s - slopes[:, :, None, None] * rel.astype(jnp.float32)
    s = jnp.where(valid[None, :, None, None], s, -jnp.inf)
    sink = sinks.astype(jnp.float32).reshape(Hkv, G)[None, None, :, :, None, None]
    m = jnp.maximum(jnp.max(s, axis=-1, keepdims=True), sink)
    p = jnp.exp(s - m)
    denom = jnp.sum(p, axis=-1, keepdims=True) + jnp.exp(sink - m)
    p = (p / denom).astype(v.dtype)
    out = jnp.einsum('bnhgqk,bnkhd->bnqhgd', p, vb)
    return out.reshape(B, S, Hkv * G * d)


def head_group_mixer(h, w_in, b_forget, swa_sinks, w_out):
    B, S, _ = h.shape
    proj = h @ w_in
    o1 = FOX_W
    o2 = 2 * FOX_W
    o3 = 3 * FOX_W
    o4 = o3 + N_FOX_HEADS
    o5 = o4 + SWA_Q_W
    o6 = o5 + SWA_KV_W
    fq, fk, fv, ff, sq, sk, sv = jnp.split(proj, [o1, o2, o3, o4, o5, o6], axis=-1)
    fshape = (B, S, N_FOX_HEADS, HEAD_DIM)
    log_f = jax.nn.log_sigmoid((ff + b_forget).astype(jnp.float32))
    fox = forgetting_attention(fq.reshape(fshape), fk.reshape(fshape), fv.reshape(fshape), log_f)
    swa = sliding_window_sink_attention(
        sq.reshape(B, S, N_SWA_KV_HEADS, SWA_GROUP, HEAD_DIM),
        sk.reshape(B, S, N_SWA_KV_HEADS, HEAD_DIM),
        sv.reshape(B, S, N_SWA_KV_HEADS, HEAD_DIM),
        swa_sinks)
    return jnp.concatenate([fox, swa], axis=-1) @ w_out


def memory_cross_attention(h, mem_n, w_cq, w_ckv, w_co):
    B, S, _ = h.shape
    M = mem_n.shape[1]
    q = (h @ w_cq).reshape(B, S, N_CROSS_HEADS, CROSS_HEAD_DIM)
    kv = (mem_n @ w_ckv).reshape(B, M, 2, N_CROSS_HEADS, CROSS_HEAD_DIM)
    k, v = kv[:, :, 0], kv[:, :, 1]
    s = jnp.einsum('bqhd,bkhd->bhqk', q, k).astype(jnp.float32) * (CROSS_HEAD_DIM ** -0.5)
    p = jax.nn.softmax(s, axis=-1).astype(v.dtype)
    o = jnp.einsum('bhqk,bkhd->bqhd', p, v).reshape(B, S, CROSS_W)
    return o @ w_co


def clamped_swiglu(u):
    x_glu = jnp.minimum(u[..., ::2], SWIGLU_LIMIT)
    x_lin = jnp.clip(u[..., 1::2], -SWIGLU_LIMIT, SWIGLU_LIMIT)
    return x_glu * jax.nn.sigmoid(SWIGLU_ALPHA * x_glu) * (x_lin + 1.0)


def routed_moe(h, w_router, b_router, w_mlp1, b_mlp1, w_mlp2, b_mlp2):
    B, S, D = h.shape
    T = B * S
    ht = h.reshape(T, D)
    logits = (ht @ w_router + b_router).astype(jnp.float32)
    top_vals, top_idx = lax.top_k(logits, TOP_K)
    gate = jax.nn.softmax(top_vals, axis=-1)
    A = T * TOP_K
    flat_e = top_idx.reshape(A)
    flat_tok = jnp.arange(A, dtype=jnp.int32) // TOP_K
    flat_gate = gate.reshape(A)
    order = jnp.argsort(flat_e)
    se = flat_e[order]
    counts = jnp.bincount(flat_e, length=N_EXPERTS)
    starts = jnp.cumsum(counts) - counts
    padded = (counts + EXPERT_BLOCK - 1) // EXPERT_BLOCK * EXPERT_BLOCK
    pends = jnp.cumsum(padded)
    pstarts = pends - padded
    dest = pstarts[se] + jnp.arange(A, dtype=jnp.int32) - starts[se]
    n_blocks = A // EXPERT_BLOCK + N_EXPERTS
    P = n_blocks * EXPERT_BLOCK
    row_tok = jnp.full((P,), T, jnp.int32).at[dest].set(flat_tok[order])
    row_gate = jnp.zeros((P,), jnp.float32).at[dest].set(flat_gate[order])
    block_e = jnp.minimum(
        jnp.searchsorted(pends, jnp.arange(n_blocks, dtype=jnp.int32) * EXPERT_BLOCK, side='right'),
        N_EXPERTS - 1)
    xrows = jnp.take(ht, row_tok, axis=0, mode='clip').reshape(n_blocks, EXPERT_BLOCK, D)

    def expert_block(args):
        xb, e = args
        u = xb @ w_mlp1[e] + b_mlp1[e]
        return clamped_swiglu(u) @ w_mlp2[e] + b_mlp2[e]

    yrows = lax.map(expert_block, (xrows, block_e)).reshape(P, D)
    out = jnp.zeros((T, D), h.dtype).at[row_tok].add(
        yrows * row_gate[:, None].astype(h.dtype), mode='drop')
    return out.reshape(B, S, D)


def setup_inputs(seed: int = 0) -> dict:
    key = jax.random.key(seed)
    ks = jax.random.split(key, 24)
    f32 = jnp.float32

    def dense(k, shape, fan_in):
        return jax.random.normal(k, shape, f32) * (fan_in ** -0.5)

    def gain(k):
        return 1.0 + 0.05 * jax.random.normal(k, (DEPTH, D_MODEL), f32)

    L, D, E, I = DEPTH, D_MODEL, N_EXPERTS, D_EXPERT
    return {
        "x": jax.random.normal(ks[0], (BATCH, SEQ, D), f32),
        "mem": jax.random.normal(ks[1], (BATCH, N_MEM, D), f32),
        "g_mix": gain(ks[2]),
        "w_in": dense(ks[3], (L, D, IN_COLS), D),
        "b_forget": 3.0 + 0.5 * jax.random.normal(ks[4], (L, N_FOX_HEADS), f32),
        "swa_sinks": 0.5 * jax.random.normal(ks[5], (L, N_SWA_HEADS), f32),
        "w_out": dense(ks[6], (L, MIX_WIDTH, D), MIX_WIDTH),
        "g_cross": gain(ks[7]),
        "g_mem": gain(ks[8]),
        "w_cq": dense(ks[9], (L, D, CROSS_W), D),
        "w_ckv": dense(ks[10], (L, D, 2 * CROSS_W), D),
        "w_co": dense(ks[11], (L, CROSS_W, D), CROSS_W),
        "g_moe": gain(ks[12]),
        "w_router": dense(ks[13], (L, D, E), D),
        "b_router": 0.01 * jax.random.normal(ks[14], (L, E), f32),
        "w_mlp1": dense(ks[15], (L, E, D, 2 * I), D),
        "b_mlp1": 0.01 * jax.random.normal(ks[16], (L, E, 2 * I), f32),
        "w_mlp2": dense(ks[17], (L, E, I, D), I),
        "b_mlp2": 0.01 * jax.random.normal(ks[18], (L, E, D), f32),
        "g_final": 1.0 + 0.05 * jax.random.normal(ks[19], (D,), f32),
    }


def reference(x, mem, g_mix, w_in, b_forget, swa_sinks, w_out, g_cross, g_mem,
              w_cq, w_ckv, w_co, g_moe, w_router, b_router, w_mlp1, b_mlp1,
              w_mlp2, b_mlp2, g_final):
    for l in range(DEPTH):
        x = x + head_group_mixer(rmsnorm(x, g_mix[l]), w_in[l], b_forget[l], swa_sinks[l], w_out[l])
        x = x + memory_cross_attention(rmsnorm(x, g_cross[l]), rmsnorm(mem, g_mem[l]),
                                       w_cq[l], w_ckv[l], w_co[l])
        x = x + routed_moe(rmsnorm(x, g_moe[l]), w_router[l], b_router[l],
                           w_mlp1[l], b_mlp1[l], w_mlp2[l], b_mlp2[l])
    return rmsnorm(x, g_final)
```

```cpp
#include <hip/hip_runtime.h>
#include <cstdio>
#include <cstdint>

#ifndef MK_ONE_LAUNCH
#define MK_ONE_LAUNCH 1
#endif

#define LAS __attribute__((address_space(3)))
#define GAS __attribute__((address_space(1)))
typedef unsigned short bf16_t;
typedef short bf16x8 __attribute__((ext_vector_type(8)));
typedef short s16x4 __attribute__((ext_vector_type(4)));
typedef float f32x4 __attribute__((ext_vector_type(4)));
typedef float f32x2 __attribute__((ext_vector_type(2)));
typedef float f32x16 __attribute__((ext_vector_type(16)));
typedef unsigned u32x4 __attribute__((ext_vector_type(4)));
typedef unsigned u32x2 __attribute__((ext_vector_type(2)));
typedef int i32x4 __attribute__((ext_vector_type(4)));
typedef int i32x8 __attribute__((ext_vector_type(8)));

constexpr int DM = 2048, NBATCH = 4, SEQ = 4096, NTOK = NBATCH * SEQ;
constexpr int HD = 64, NFOX = 16, NSWA = 16, NSKV = 4, WINDOW = 128;
constexpr int NMEM = 256, NCH = 4, CHD = 128, CW = NCH * CHD;
constexpr int NE = 32, TOPK = 4, DE = 2048;
constexpr int IN_COLS = 4624, INP = 4864;
constexpr float RMS_EPS = 1e-5f;
constexpr float LOG2E = 1.4426950408889634f;
constexpr float C2_64 = 0.125f * LOG2E;
constexpr float C2_128 = 0.08838834764831845f * LOG2E;
constexpr int ECAP = NTOK;
constexpr float WSCALE = 64.0f, WSCALE_INV = 1.0f / 64.0f;

constexpr size_t MiB = 1u << 20;
constexpr size_t WS_CTL = 0, CTL_ZERO_BYTES = 1 * MiB;
constexpr size_t WS_WIN = 2 * MiB, WS_WOUT = 22 * MiB, WS_WCQ = 30 * MiB, WS_WCKV = 32 * MiB, WS_WCO = 36 * MiB, WS_MEMB = 38 * MiB;
constexpr size_t WS_RSTD0 = 42 * MiB, WS_RSTDM = 42 * MiB + 65536, WS_WRG = 42 * MiB + 131072  , WS_LOGF = 43 * MiB, WS_RSTD2 = 44 * MiB;
constexpr size_t WS_ROWLIST = 45 * MiB, WS_ROWGATE = 47 * MiB, WS_CKV = 50 * MiB, WS_ROWRS = 52 * MiB;
constexpr size_t WS_XB = 64 * MiB, WS_FQ = 128 * MiB, WS_FK = 160 * MiB, WS_FV = 192 * MiB, WS_SQ = 224 * MiB, WS_SK = 256 * MiB, WS_SV = 264 * MiB;
constexpr size_t WS_AO = 288 * MiB, WS_X1 = 352 * MiB, WS_X1B = 480 * MiB, WS_CQ = 544 * MiB, WS_CO = 560 * MiB, WS_X2 = 576 * MiB, WS_X2B = 704 * MiB;
constexpr size_t WS_W1 = 768 * MiB, WS_W2 = 1280 * MiB, WS_H = 1536 * MiB, WS_Y = 1824 * MiB, WS_END = 2080 * MiB;
constexpr int CW_TMO = 0, CW_CODE = 1, CW_BAR = 4096, CW_CNT = 8192, CW_KMAX = 8320  , CW_Q2 = 8512  , CW_CVT9 = 12288  , CW_SSQ1 = 16384, CW_SSQ2 = 32768;

constexpr int RING_BYTES = 131072;
constexpr int BG_G_OFF = 49152;
constexpr int BG_OFF = 90112;
constexpr int TAB_OFF = 161792;
constexpr int MISC_OFF = TAB_OFF + 1024;
constexpr int LDS_BYTES = 163840;
constexpr int NWAVES = 8, NTHREADS = 512;

#define RLX_AGENT __ATOMIC_RELAXED, __HIP_MEMORY_SCOPE_AGENT
#define LDS_WAIT() asm volatile("s_waitcnt lgkmcnt(0)" ::: "memory")
#define VM_WAIT() asm volatile("s_waitcnt vmcnt(0)" ::: "memory")
__device__ __forceinline__ unsigned f2bf(float f) { unsigned u = __builtin_bit_cast(unsigned, f); return (u + 0x7fffu + ((u >> 16) & 1u)) >> 16; }
__device__ __forceinline__ unsigned pk2(float lo, float hi) { return f2bf(lo) | (f2bf(hi) << 16); }
__device__ __forceinline__ unsigned cvt_pk_bf16(float lo, float hi) { unsigned r; asm volatile("v_cvt_pk_bf16_f32 %0, %1, %2" : "=v"(r) : "v"(lo), "v"(hi)); return r; }
__device__ __forceinline__ unsigned pk4_fp8(float a, float b, float c, float d) { int w = __builtin_amdgcn_cvt_pk_fp8_f32(a, b, 0, false); w = __builtin_amdgcn_cvt_pk_fp8_f32(c, d, w, true); return (unsigned)w; }
__device__ __forceinline__ float bf_lo(unsigned w) { return __builtin_bit_cast(float, w << 16); }
__device__ __forceinline__ float bf_hi(unsigned w) { return __builtin_bit_cast(float, w & 0xffff0000u); }
__device__ __forceinline__ float wave_sum(float v) {
#pragma unroll
    for (int o = 1; o < 64; o <<= 1) v += __shfl_xor(v, o);
    return v;
}

#define XB_TMO      128
#define XB_XCNT(j)  (256  + 64 * (j))
#define XB_XSUB(j)  (1280 + 64 * (j))
#define XB_XGEN(j)  (2304 + 64 * (j))
#define XB_TOP      3328
#define XB_TOPGEN   3392
#define XCD_BAR_WORDS 3456
#define XB_SPIN_CAP (1u << 18)
__device__ __forceinline__ unsigned xb_ld(unsigned* p)              { return __hip_atomic_load(p, __ATOMIC_RELAXED, __HIP_MEMORY_SCOPE_AGENT); }
__device__ __forceinline__ unsigned xb_add(unsigned* p, unsigned v) { return __hip_atomic_fetch_add(p, v, __ATOMIC_RELAXED, __HIP_MEMORY_SCOPE_AGENT); }
__device__ __forceinline__ unsigned xb_xcc_id() { return (unsigned)__builtin_amdgcn_s_getreg((3 << 11) | 20) & 0xFu; }
#define XB_SPIN(cond, bar) do { unsigned _sp = 0; while (cond) { __builtin_amdgcn_s_sleep(1); \
    if ((++_sp & 255u) == 0u) { if (xb_ld(&(bar)[XB_TMO])) break; if (_sp > XB_SPIN_CAP) { atomicAdd(&(bar)[XB_TMO], 1u); break; } } } } while (0)
struct XcdBarrier { unsigned* bar; unsigned x; volatile LAS unsigned* st; };
__device__ __forceinline__ XcdBarrier xcd_barrier_post(unsigned* bar, volatile LAS unsigned* st) {
    XcdBarrier b; b.bar = bar; b.x = xb_xcc_id(); b.st = st;
    if (threadIdx.x == 0) (void)xb_add(&bar[XB_XCNT(b.x)], 1u);
    return b;
}
__device__ __forceinline__ void xcd_barrier_complete(unsigned* bar, unsigned x, unsigned& nloc, unsigned& nx) {
    const unsigned G = gridDim.x * gridDim.y * gridDim.z;
    unsigned sum, cnt, mine, sp = 0u;
    for (;;) {
        sum = 0u; cnt = 0u; mine = 0u;
#pragma unroll
        for (unsigned j = 0; j < 16; ++j) { const unsigned c = xb_ld(&bar[XB_XCNT(j)]); sum += c; cnt += (c > 0u) ? 1u : 0u; mine = (j == x) ? c : mine; }
        if (sum == G) break;
        __builtin_amdgcn_s_sleep(1);
        if ((++sp & 255u) == 0u) { if (xb_ld(&bar[XB_TMO])) break; if (sp > XB_SPIN_CAP) { atomicAdd(&bar[XB_TMO], 1u); break; } }
    }
    nloc = mine > 0u ? mine : 1u; nx = cnt > 0u ? cnt : 1u;
}
__device__ __forceinline__ void xcd_barrier(const XcdBarrier& b) {
    asm volatile("s_waitcnt vmcnt(0)" ::: "memory");
    __syncthreads();
    if (threadIdx.x == 0) {
        unsigned* bar = b.bar;
        __builtin_amdgcn_s_waitcnt(0);
        unsigned nloc = b.st[0], nx = b.st[1];
        if (nloc == 0u) { xcd_barrier_complete(bar, b.x, nloc, nx); b.st[0] = nloc; b.st[1] = nx; }
        const unsigned old = xb_add(&bar[XB_XSUB(b.x)], 1u);
        const unsigned gen = old / nloc;
        if (old + 1u == (gen + 1u) * nloc) {
            __builtin_amdgcn_fence(__ATOMIC_RELEASE, "agent");
            asm volatile("s_waitcnt vmcnt(0)" ::: "memory");
            const unsigned og = xb_add(&bar[XB_TOP], 1u);
            const unsigned tg = og / nx;
            if (og + 1u == (tg + 1u) * nx) xb_add(&bar[XB_TOPGEN], 1u);
            else XB_SPIN(xb_ld(&bar[XB_TOPGEN]) == tg, bar);
            __builtin_amdgcn_fence(__ATOMIC_ACQUIRE, "agent");
            xb_add(&bar[XB_XGEN(b.x)], 1u);
            asm volatile("s_waitcnt vmcnt(0)" ::: "memory");
        } else {
            XB_SPIN(xb_ld(&bar[XB_XGEN(b.x)]) == gen, bar);
            __builtin_amdgcn_fence(__ATOMIC_ACQUIRE, "agent");
            asm volatile("s_waitcnt vmcnt(0)" ::: "memory");
        }
    }
    __syncthreads();
}

namespace pg8 {
constexpr int BM = 256, BK = 64, HALF = 128, HTB = HALF * BK * 2, STAGE_BYTES = 8 * HTB, NXCD = 8, WGM = 8;
__host__ __device__ __forceinline__ int lds_byte(int r, int c) { const int st = (r >> 4) * 2 + (c >> 5), rr = r & 15, cc = c & 31, ob = rr * 64 + cc * 2; return st * 1024 + (ob ^ (((ob >> 9) & 1) << 5)); }
__host__ __device__ __forceinline__ void stage_rc(int b, int& R, int& C) { const int st = b / 1024, sb = b % 1024, swz = sb ^ (((sb >> 9) & 1) << 5); R = (st >> 1) * 16 + swz / 64; C = (st & 1) * 32 + (swz % 64) / 2; }
__host__ __device__ __forceinline__ int perm32(int rho) { const int n = rho >> 4, i = rho & 15; return 8 * (i >> 2) + 4 * n + (i & 3); }

struct Unit { int pm, pn, e, aux; };

__device__ __forceinline__ bool grid_order(int L, int nM, int nN, int& pm, int& pn) {
    const int nwg = nM * nN; if (L >= nwg) return false;
    int wgid = L; { const int q = nwg / NXCD, r = nwg % NXCD, xcd = wgid % NXCD, off = wgid / NXCD; wgid = (xcd < r ? xcd * (q + 1) : r * (q + 1) + (xcd - r) * q) + off; }
    const int nig = WGM * nN, gid = wgid / nig, fm = gid * WGM, gsz = (nM - fm) < WGM ? (nM - fm) : WGM;
    pm = fm + ((wgid % nig) % gsz); pn = (wgid % nig) / gsz; return true;
}

template <class Epi, class Sched, bool ALIGN_EPI, bool SP2, bool FP8 = false>
__device__ __forceinline__ void gemm_phase(LAS unsigned char* lds, const int K, const Sched& S, const Epi& E) {
    const int tid = threadIdx.x, wid = __builtin_amdgcn_readfirstlane(tid >> 6), lane = tid & 63, wr = wid >> 2, wc = wid & 3, fr = lane & 15, fq = lane >> 4;
    const int nt = K / BK;
    unsigned voffB[2];
#pragma unroll
    for (int i = 0; i < 2; ++i) { int R, C; stage_rc(tid * 16 + i * 8192, R, C); const int Rb = Epi::PERM ? ((R & ~31) + perm32(R & 31)) : R;
        voffB[i] = (unsigned)(Rb * K + C) * 2u; }
    const size_t kstep = (size_t)(BK * 2);
    const size_t hstep = (size_t)HALF * K * 2;
    const unsigned ldsw = (unsigned)wid * 1024u;
    const int aoff = lds_byte(wr * 64 + fr, fq * 8), boff = lds_byte(wc * 32 + fr, fq * 8);
#define PG8_SA(b, h) (((b) * 2 + (h)) * HTB)
#define PG8_SB(b, h) ((4 + (b) * 2 + (h)) * HTB)
#define PG8_STAGE(bufoff, gbase, voff) do { _Pragma("unroll") for (int _i = 0; _i < 2; ++_i) \
        __builtin_amdgcn_global_load_lds((const unsigned*)((const char*)(gbase) + (voff)[_i]), (LAS unsigned*)(lds + (bufoff) + ldsw + _i * 8192), 16, 0, 0); } while (0)
#define PG8_LD8(p) __builtin_shufflevector(*(const LAS i32x4*)(p), *(const LAS i32x4*)((p) + 1024), 0, 1, 2, 3, 4, 5, 6, 7)
#define PG8_LDA(dst, b, h) do { if constexpr (FP8) { _Pragma("unroll") for (int m = 0; m < 4; ++m) dst##8[m] = PG8_LD8(lds + PG8_SA(b, h) + aoff + m * 2048); } \
        else { _Pragma("unroll") for (int m = 0; m < 4; ++m) _Pragma("unroll") for (int k = 0; k < 2; ++k) dst[m][k] = *(const LAS bf16x8*)(lds + PG8_SA(b, h) + aoff + m * 2048 + k * 1024); } } while (0)
#define PG8_LDB(dst, b, h) do { if constexpr (FP8) { _Pragma("unroll") for (int n = 0; n < 2; ++n) dst##8[n] = PG8_LD8(lds + PG8_SB(b, h) + boff + n * 2048); } \
        else { _Pragma("unroll") for (int n = 0; n < 2; ++n) _Pragma("unroll") for (int k = 0; k < 2; ++k) dst[n][k] = *(const LAS bf16x8*)(lds + PG8_SB(b, h) + boff + n * 2048 + k * 1024); } } while (0)
#define PG8_MMA(ai, bj, At, Bt) do { __builtin_amdgcn_s_setprio(1); \
        if constexpr (FP8) { _Pragma("unroll") for (int m = 0; m < 4; ++m) _Pragma("unroll") for (int n = 0; n < 2; ++n) \
            asm("v_mfma_f32_16x16x128_f8f6f4 %0, %1, %2, %0" : "+v"(acc[ai][bj][m][n]) : "v"(Bt##8[n]), "v"(At##8[m])); } \
        else { _Pragma("unroll") for (int m = 0; m < 4; ++m) _Pragma("unroll") for (int n = 0; n < 2; ++n) _Pragma("unroll") for (int k = 0; k < 2; ++k) \
            acc[ai][bj][m][n] = __builtin_amdgcn_mfma_f32_16x16x32_bf16(Bt[n][k], At[m][k], acc[ai][bj][m][n], 0, 0, 0); } \
        __builtin_amdgcn_s_setprio(0); } while (0)
#define PG8_WAIT_V(n) asm volatile("s_waitcnt vmcnt(" #n ")" ::: "memory")
#define PG8_WAIT_L(n) asm volatile("s_waitcnt lgkmcnt(" #n ")" ::: "memory")
#define PG8_BAR __builtin_amdgcn_s_barrier()
#define PG8_SCHED __builtin_amdgcn_sched_barrier(0)
#define PG8_AOFF(dst, u) do { int _t = tid; asm volatile("" : "+v"(_t)); _Pragma("unroll") for (int _i = 0; _i < 2; ++_i) { int _R, _C; stage_rc(_t * 16 + _i * 8192, _R, _C); \
        _Pragma("unroll") for (int _h = 0; _h < 2; ++_h) dst[_h][_i] = S.a_off(u, _h * HALF + _R) + (unsigned)_C * 2u; } \
        if (Sched::GATHER) { asm volatile("s_waitcnt vmcnt(0)" ::: "memory"); } } while (0)
    Unit cur, nxt; int ui = 0;
    if (!S.next(0, cur)) return;
    f32x4 acc[2][2][4][2];
#pragma unroll
    for (int a = 0; a < 2; ++a)
#pragma unroll
        for (int b = 0; b < 2; ++b)
#pragma unroll
            for (int m = 0; m < 4; ++m)
#pragma unroll
                for (int n = 0; n < 2; ++n) acc[a][b][m][n] = (f32x4){0.f, 0.f, 0.f, 0.f};
    bf16x8 At[4][2], B0[2][2], B1[2][2]; i32x8 At8[4], B08[2], B18[2];
    unsigned vAc[2][2], vAn[2][2];
    PG8_AOFF(vAc, cur);
    const char* cA = S.a_base(cur); const char* cB = S.b_base(cur);
    static_assert(SP2, "only the SP2 loop is kept");
    PG8_STAGE(PG8_SB(0, 0), cB, voffB); PG8_STAGE(PG8_SB(0, 1), cB + hstep, voffB); PG8_STAGE(PG8_SA(0, 0), cA, vAc[0]); PG8_STAGE(PG8_SA(0, 1), cA, vAc[1]);
    if (wr == 1) PG8_BAR;
    PG8_WAIT_V(2); PG8_BAR;
    PG8_STAGE(PG8_SB(1, 0), cB + kstep, voffB); PG8_STAGE(PG8_SA(1, 0), cA + kstep, vAc[0]); PG8_STAGE(PG8_SB(1, 1), cB + hstep + kstep, voffB);
    PG8_WAIT_V(6); PG8_BAR;
    for (;;) {
        const bool has_next = S.next(ui + 1, nxt);
        const char* nA = cA; const char* nB = cB;
        if (has_next) { nA = S.a_base(nxt); nB = S.b_base(nxt); PG8_AOFF(vAn, nxt); }
        else {
#pragma unroll
            for (int h = 0; h < 2; ++h)
#pragma unroll
                for (int i = 0; i < 2; ++i) vAn[h][i] = vAc[h][i];
        }
        for (int t = 0; t < nt; t += 2) {
            const bool last = (t == nt - 2);
            const char* a1 = cA + (size_t)(t + 1) * kstep;
            const char* a2 = last ? nA : cA + (size_t)(t + 2) * kstep; const char* b2 = last ? nB : cB + (size_t)(t + 2) * kstep;
            const char* a3 = a2 + kstep; const char* b3 = b2 + kstep;
            unsigned vX0[2], vX1[2];
#pragma unroll
            for (int i = 0; i < 2; ++i) { vX0[i] = last ? vAn[0][i] : vAc[0][i]; vX1[i] = last ? vAn[1][i] : vAc[1][i]; }
            PG8_LDB(B0, 0, 0); PG8_LDB(B1, 0, 1); PG8_SCHED; PG8_LDA(At, 0, 0); PG8_STAGE(PG8_SA(1, 1), a1, vAc[1]);
            PG8_WAIT_V(8); PG8_WAIT_L(0); PG8_BAR; PG8_MMA(0, 0, At, B0); PG8_MMA(0, 1, At, B1); PG8_BAR; PG8_SCHED;
            PG8_LDA(At, 0, 1); PG8_STAGE(PG8_SB(0, 0), b2, voffB); PG8_STAGE(PG8_SB(0, 1), b2 + hstep, voffB); PG8_STAGE(PG8_SA(0, 0), a2, vX0);
            PG8_WAIT_V(8); PG8_WAIT_L(0); PG8_BAR; PG8_MMA(1, 0, At, B0); PG8_MMA(1, 1, At, B1); PG8_BAR; PG8_SCHED;
            PG8_LDB(B0, 1, 0); PG8_LDB(B1, 1, 1); PG8_SCHED; PG8_LDA(At, 1, 0); PG8_STAGE(PG8_SA(0, 1), a2, vX1);
            PG8_WAIT_V(8); PG8_WAIT_L(0); PG8_BAR; PG8_MMA(0, 0, At, B0); PG8_MMA(0, 1, At, B1); PG8_BAR; PG8_SCHED;
            PG8_LDA(At, 1, 1); PG8_STAGE(PG8_SB(1, 0), b3, voffB); PG8_STAGE(PG8_SB(1, 1), b3 + hstep, voffB); PG8_STAGE(PG8_SA(1, 0), a3, vX0);
            PG8_WAIT_V(8); PG8_WAIT_L(0); PG8_BAR; PG8_MMA(1, 0, At, B0); PG8_MMA(1, 1, At, B1); PG8_BAR; PG8_SCHED;
        }
        if constexpr (ALIGN_EPI) { if (wr == 0) PG8_BAR; }
        if constexpr (FP8) { asm volatile("s_nop 15\n\ts_nop 15" ::: "memory"); }
        E(acc, cur, wr, wc, fr, fq);
        if (!has_next) break;
#pragma unroll
        for (int a = 0; a < 2; ++a)
#pragma unroll
            for (int b = 0; b < 2; ++b)
#pragma unroll
                for (int m = 0; m < 4; ++m)
#pragma unroll
                    for (int n = 0; n < 2; ++n) acc[a][b][m][n] = (f32x4){0.f, 0.f, 0.f, 0.f};
        cur = nxt; cA = nA; cB = nB; ++ui;
#pragma unroll
        for (int h = 0; h < 2; ++h)
#pragma unroll
            for (int i = 0; i < 2; ++i) vAc[h][i] = vAn[h][i];
        if constexpr (ALIGN_EPI) { if (wr == 1) PG8_BAR; }
    }
    PG8_WAIT_V(0);
    if constexpr (!ALIGN_EPI) { if (wr == 0) PG8_BAR; }
    PG8_BAR;
#undef PG8_SA
#undef PG8_SB
#undef PG8_STAGE
#undef PG8_LDA
#undef PG8_LDB
#undef PG8_MMA
#undef PG8_LD8
#undef PG8_WAIT_V
#undef PG8_WAIT_L
#undef PG8_BAR
#undef PG8_SCHED
#undef PG8_AOFF
}
}

namespace att {
constexpr int KOFF = 0, VOFF = 32768, WSF_OFF = 65536, C_OFF = 69632, ATT_LDS = C_OFF + 16384;
constexpr float THR = 8.0f;
typedef short v4i16_t __attribute__((ext_vector_type(4)));
__device__ __forceinline__ int crow(int r, int hi) { return (r & 3) + 8 * (r >> 2) + 4 * hi; }
__device__ __forceinline__ float max3f(float a, float b, float c) { return __builtin_fmaxf(__builtin_fmaxf(a, b), c); }
__device__ __forceinline__ unsigned cvtpk(float lo, float hi) { typedef __bf16 bf16x2_t __attribute__((ext_vector_type(2))); f32x2 v = {lo, hi}; bf16x2_t b = __builtin_convertvector(v, bf16x2_t); return __builtin_bit_cast(unsigned, b); }
__device__ __forceinline__ s16x4 vtr(const LAS unsigned char* p) { return __builtin_bit_cast(s16x4, __builtin_amdgcn_ds_read_tr16_b64_v4i16((LAS v4i16_t*)p)); }

struct Prm {
    const bf16_t* Q; int qp;
    const bf16_t* K; int kp;
    const bf16_t* V; int vp;
    bf16_t* O; int op;
    int q0;
    int kt0, kt1;
    int nkeys;
    int window;
    const LAS float* c; int cpos0;
    float sink2;
    float kmaxA, kmaxB;
};

struct NoBg { __device__ __forceinline__ bool inflight() const { return false; } __device__ __forceinline__ void tick() {} __device__ __forceinline__ void issue() {} };
template <int D, bool MASK, bool BIAS, bool SINK, bool REV, bool O8, class BG>
__device__ __forceinline__ void attn_unit(const Prm& P, LAS unsigned char* lds, BG& bg) {
    constexpr int NCHK = D / 8, KSLOT = 64 * D * 2, NDB = D / 32, NKS = D / 16;
    const int tid = threadIdx.x, lane = tid & 63, r32 = lane & 31, hi = lane >> 5; const int wid = __builtin_amdgcn_readfirstlane(tid >> 6);
    LAS float* wsf = (LAS float*)(lds + WSF_OFF) + wid * 64;
    const int qw = P.q0 + wid * 32, qpos = qw + r32;
    auto dma_tile = [&](int t, int s) {
        const int kbase = t * 64;
#pragma unroll
        for (int cc = 0; cc < NCHK / 8; ++cc) {
            const int ch = wid + 8 * cc;
            int row = kbase + lane; row = row < 0 ? 0 : (row >= P.nkeys ? P.nkeys - 1 : row);
            __builtin_amdgcn_global_load_lds((const unsigned*)(P.K + (size_t)row * P.kp + ch * 8), (LAS unsigned*)(lds + KOFF + s * KSLOT + ch * 1024), 16, 0, 0);
            const int dblk = ch >> 2, rg = ch & 3;
            int vrow = kbase + 16 * rg + (lane >> 2); vrow = vrow < 0 ? 0 : (vrow >= P.nkeys ? P.nkeys - 1 : vrow);
            __builtin_amdgcn_global_load_lds((const unsigned*)(P.V + (size_t)vrow * P.vp + dblk * 32 + (lane & 3) * 8), (LAS unsigned*)(lds + VOFF + s * KSLOT + ch * 1024), 16, 0, 0);
        }
    };
    dma_tile(REV ? P.kt1 - 1 : P.kt0, 0);
    bf16x8 qr[NKS];
#pragma unroll
    for (int d0 = 0; d0 < NKS; ++d0) qr[d0] = *(const bf16x8*)(P.Q + (size_t)(wid * 32 + r32) * P.qp + d0 * 16 + hi * 8);
    const float cq = BIAS ? P.c[qpos - P.cpos0] : 0.f;
    float mhat = SINK ? P.sink2 : 0.f, l_reg = (SINK && hi == 0) ? 1.f : 0.f;
    bool first = !SINK;
    f32x16 o[NDB];
#pragma unroll
    for (int d = 0; d < NDB; ++d) o[d] = f32x16{};
    float qbnd = 0.f;
    if (REV) {
        float a = 0.f, b = 0.f;
#pragma unroll
        for (int d0 = 0; d0 < NKS; ++d0)
#pragma unroll
            for (int j = 0; j < 8; ++j) { const float v = __builtin_bit_cast(float, (unsigned)(unsigned short)qr[d0][j] << 16); if (d0 < NKS / 2) a += v * v; else b += v * v; }
        { auto rr = __builtin_amdgcn_permlane32_swap(__float_as_uint(a), __float_as_uint(a), false, false); a = __uint_as_float(rr[0]) + __uint_as_float(rr[1]); }
        { auto rr = __builtin_amdgcn_permlane32_swap(__float_as_uint(b), __float_as_uint(b), false, false); b = __uint_as_float(rr[0]) + __uint_as_float(rr[1]); }
        qbnd = 1.02f * (sqrtf(a) * P.kmaxA + sqrtf(b) * P.kmaxB) + 30.0f + cq;
    }
    LAS int* nflag = (LAS int*)(lds + WSF_OFF + 2048);
    int need_cur = 1, need_nxt = 1;
    const int NT = P.kt1 - P.kt0;
    for (int k = 0; k < NT; ++k) {
        const int t = REV ? P.kt1 - 1 - k : P.kt0 + k;
        const int s = k & 1, kbase = t * 64;
        if (k != 0 && bg.inflight()) asm volatile("s_waitcnt vmcnt(16)" ::: "memory");
        else asm volatile("s_waitcnt vmcnt(0)" ::: "memory");
        __syncthreads();
        bool more = k + 1 < NT;
        if (REV && more && k >= 1) { int any = 0;
#pragma unroll
            for (int w = 0; w < 8; ++w) any |= nflag[((k - 1) & 1) * 8 + w];
            more = any != 0; }
        bg.tick();
        if (more) dma_tile(REV ? t - 1 : t + 1, s ^ 1);
        bg.issue();
        bool compute = true, need_mask = false;
        if (MASK) {
            compute = !(kbase > qw + 31 || kbase + 63 < qw - P.window + 1) && (!REV || need_cur != 0);
            need_mask = (kbase + 63 > qw) || (kbase < qw + 31 - P.window + 1) || (kbase < 0);
        }
        if (compute) {
            const float cinit = cq - mhat;
            f32x16 p0, p1;
#pragma unroll
            for (int r = 0; r < 16; ++r) { p0[r] = cinit; p1[r] = cinit; }
            const LAS unsigned char* ks = lds + KOFF + s * KSLOT + hi * 1024 + r32 * 16;
#pragma unroll
            for (int d0 = 0; d0 < NKS; ++d0) {
                const bf16x8 b0 = *(const LAS bf16x8*)(ks + d0 * 2048), b1 = *(const LAS bf16x8*)(ks + d0 * 2048 + 512);
                p0 = __builtin_amdgcn_mfma_f32_32x32x16_bf16(b0, qr[d0], p0, 0, 0, 0);
                p1 = __builtin_amdgcn_mfma_f32_32x32x16_bf16(b1, qr[d0], p1, 0, 0, 0);
            }
            if (BIAS) {
                const LAS float* cb = P.c + (kbase - P.cpos0) + 4 * hi;
#pragma unroll
                for (int g = 0; g < 4; ++g) {
                    const f32x4 a = *(const LAS f32x4*)(cb + 8 * g), b = *(const LAS f32x4*)(cb + 32 + 8 * g);
#pragma unroll
                    for (int j = 0; j < 4; ++j) { p0[4 * g + j] -= a[j]; p1[4 * g + j] -= b[j]; }
                }
            }
            if (MASK && need_mask) {
                const int dq = qpos - kbase; int lo = dq - P.window + 1; lo = lo > -kbase ? lo : -kbase;
                const int lo2 = lo - 4 * hi, hi2 = dq - 4 * hi;
#pragma unroll
                for (int r = 0; r < 16; ++r) {
                    const int kr = (r & 3) + 8 * (r >> 2);
                    if (!(kr >= lo2 && kr <= hi2)) p0[r] = -INFINITY;
                    if (!(kr + 32 >= lo2 && kr + 32 <= hi2)) p1[r] = -INFINITY;
                }
            }
            float a = max3f(p0[0], p0[1], p1[0]), b = max3f(p0[2], p0[3], p1[1]); a = max3f(a, p1[2], p1[3]);
#pragma unroll
            for (int r = 4; r < 16; r += 4) { a = max3f(a, p0[r], p0[r + 1]); b = max3f(b, p0[r + 2], p0[r + 3]); a = max3f(a, p1[r], p1[r + 1]); b = max3f(b, p1[r + 2], p1[r + 3]); }
            float rm = __builtin_fmaxf(a, b);
            { auto rr = __builtin_amdgcn_permlane32_swap(__float_as_uint(rm), __float_as_uint(rm), false, false); rm = __builtin_fmaxf(__uint_as_float(rr[0]), __uint_as_float(rr[1])); }
            if (first || __any(rm > THR)) {
                float dl = first ? rm : __builtin_fmaxf(rm, 0.f);
                if (!(dl > -1e30f)) dl = 0.f;
                mhat += dl;
#pragma unroll
                for (int r = 0; r < 16; ++r) { p0[r] -= dl; p1[r] -= dl; }
                if (!first) {
                    const float f = __builtin_amdgcn_exp2f(-dl); l_reg *= f;
                    if (hi == 0) wsf[r32] = f;
                    LDS_WAIT();
#pragma unroll
                    for (int g = 0; g < 4; ++g) { const f32x4 fv = *(const LAS f32x4*)(wsf + 8 * g + 4 * hi);
#pragma unroll
                        for (int d = 0; d < NDB; ++d)
#pragma unroll
                            for (int j = 0; j < 4; ++j) o[d][4 * g + j] *= fv[j]; }
                }
                first = false;
            }
            float sacc = 0.f;
#pragma unroll
            for (int r = 0; r < 16; ++r) { p0[r] = __builtin_amdgcn_exp2f(p0[r]); p1[r] = __builtin_amdgcn_exp2f(p1[r]); sacc += p0[r] + p1[r]; }
            l_reg += sacc;
            u32x4 pw[4];
#pragma unroll
            for (int q = 0; q < 4; ++q) { pw[0][q] = cvtpk(p0[2 * q], p0[2 * q + 1]); pw[1][q] = cvtpk(p0[8 + 2 * q], p0[9 + 2 * q]); pw[2][q] = cvtpk(p1[2 * q], p1[2 * q + 1]); pw[3][q] = cvtpk(p1[8 + 2 * q], p1[9 + 2 * q]); }
            const LAS unsigned char* vs = lds + VOFF + s * KSLOT + ((lane >> 4) & 1) * 32 + (lane & 3) * 8 + (4 * hi + ((lane & 15) >> 2)) * 64;
#pragma unroll
            for (int d = 0; d < NDB; ++d)
#pragma unroll
                for (int k4 = 0; k4 < 4; ++k4) {
                    const s16x4 vlo = vtr(vs + d * 4096 + k4 * 1024), vhi = vtr(vs + d * 4096 + k4 * 1024 + 512);
                    const bf16x8 vf = (bf16x8){vlo[0], vlo[1], vlo[2], vlo[3], vhi[0], vhi[1], vhi[2], vhi[3]};
                    o[d] = __builtin_amdgcn_mfma_f32_32x32x16_bf16(__builtin_bit_cast(bf16x8, pw[k4]), vf, o[d], 0, 0, 0);
                }
        }
        if (REV) {
            int nn = 0;
            if (t - 2 >= P.kt0) { const float ck = P.c[64 * (t - 1) - 1 - P.cpos0]; nn = (first || __any(qbnd - ck - mhat >= 0.f)) ? 1 : 0; }
            if (lane == 0) nflag[(k & 1) * 8 + wid] = nn;
            need_cur = need_nxt; need_nxt = nn;
            if (!more) break;
        }
    }
    { auto rr = __builtin_amdgcn_permlane32_swap(__float_as_uint(l_reg), __float_as_uint(l_reg), false, false); l_reg = __uint_as_float(rr[0]) + __uint_as_float(rr[1]); }
    if (hi == 0) wsf[32 + r32] = l_reg;
    LDS_WAIT();
    float rli[16];
#pragma unroll
    for (int g = 0; g < 4; ++g) { const f32x4 lv = *(const LAS f32x4*)(wsf + 32 + 8 * g + 4 * hi);
#pragma unroll
        for (int j = 0; j < 4; ++j) rli[4 * g + j] = __builtin_amdgcn_rcpf(lv[j]); }
    __syncthreads();
    int ln = lane; asm volatile("" : "+v"(ln));
    const int r32e = ln & 31, hie = ln >> 5;
    if constexpr (O8) {
        LAS unsigned char* stg = lds + wid * (32 * D) + (4 * hie) * D + r32e;
#pragma unroll
        for (int r = 0; r < 16; ++r) { const int orow = (r & 3) + 8 * (r >> 2);
#pragma unroll
            for (int d = 0; d < NDB; ++d) { const float v = o[d][r] * rli[r]; stg[orow * D + d * 32] = (unsigned char)(__builtin_amdgcn_cvt_pk_fp8_f32(v, v, 0, false) & 0xff); } }
        LDS_WAIT();
        constexpr int CPR = D / 16, RPI = 64 / CPR;
        const LAS unsigned char* stg2 = lds + wid * (32 * D) + (ln / CPR) * D + (ln % CPR) * 16;
        unsigned char* Ow = (unsigned char*)P.O + (size_t)(wid * 32 + ln / CPR) * P.op + (ln % CPR) * 16;
#pragma unroll
        for (int i = 0; i < 32 / RPI; ++i) { const u32x4 v = *(const LAS u32x4*)(stg2 + i * RPI * D); *(u32x4*)(Ow + (size_t)(i * RPI) * P.op) = v; }
    } else {
    LAS bf16_t* stg = (LAS bf16_t*)(lds + wid * (32 * D * 2)) + (4 * hie) * D + r32e;
#pragma unroll
    for (int r = 0; r < 16; ++r) { const int orow = (r & 3) + 8 * (r >> 2);
#pragma unroll
        for (int d = 0; d < NDB; ++d) stg[orow * D + d * 32] = (bf16_t)f2bf(o[d][r] * rli[r]); }
    LDS_WAIT();
    constexpr int CPR = D / 8, RPI = 64 / CPR;
    const LAS bf16_t* stg2 = (const LAS bf16_t*)(lds + wid * (32 * D * 2)) + (ln / CPR) * D + (ln % CPR) * 8;
    bf16_t* Ow = P.O + (size_t)(wid * 32 + ln / CPR) * P.op + (ln % CPR) * 8;
#pragma unroll
    for (int i = 0; i < 32 / RPI; ++i) { const u32x4 v = *(const LAS u32x4*)(stg2 + i * RPI * D); *(u32x4*)(Ow + (size_t)(i * RPI) * P.op) = v; }
    }
    LDS_WAIT();
    __syncthreads();
}
}

struct Frame {
    LAS unsigned char* lds; volatile LAS unsigned* MISC; unsigned* ctl;
    int tid, lane, wave, vcu, G;
    const float *x, *mem, *g_mix, *w_in, *b_forget, *sinks, *w_out, *g_cross, *g_mem, *w_cq, *w_ckv, *w_co, *g_moe, *w_router, *b_router, *w_mlp1, *b_mlp1, *w_mlp2, *b_mlp2, *g_final;
    float* out; unsigned char* ws;
};
#define WSP(T, off) ((T*)(F.ws + (off)))

template <int MAP> __device__ __forceinline__ int rowmap(int n) {
    if (MAP == 1) return n < 3072 ? n : (n < 3088 ? 4608 + (n - 3072) : n - 16);
    if (MAP == 2) { const int o = n >> 1, bj = n & 1; return 256 * (o >> 7) + 128 * bj + (o & 127); }
    return n;
}
__device__ __forceinline__ int tr_rowmap(int map, int n) { return map == 1 ? (n < 3072 ? n : (n < 3088 ? 4608 + (n - 3072) : n - 16)) : n; }
__device__ __forceinline__ void tr_load(float (&v)[32], const float* W, int ldw, int ncols, int k0, int n0, int lane) {
    int nn = n0 + (lane & 31); nn = nn < ncols ? nn : ncols - 1;
    const float* p = W + (size_t)(k0 + (lane >> 5)) * ldw + nn;
#pragma unroll
    for (int i = 0; i < 32; ++i) v[i] = p[(size_t)(2 * i) * ldw];
}
__device__ __forceinline__ void tr_store(bf16_t* WT, const float* g, int ncols, int K, int map, int k0, int n0, LAS float* scr, int lane) {
    const int c = lane & 7;
    f32x4 g0 = (f32x4){1.f, 1.f, 1.f, 1.f}, g1 = g0;
    if (g) { g0 = *(const f32x4*)(g + k0 + 8 * c); g1 = *(const f32x4*)(g + k0 + 8 * c + 4); }
#pragma unroll
    for (int j = 0; j < 4; ++j) { const int nl = (lane >> 3) + 8 * j, n = n0 + nl; const LAS float* s = scr + (8 * c) * 33 + nl;
        u32x4 o; o.x = pk2(s[0 * 33] * g0[0], s[1 * 33] * g0[1]); o.y = pk2(s[2 * 33] * g0[2], s[3 * 33] * g0[3]); o.z = pk2(s[4 * 33] * g1[0], s[5 * 33] * g1[1]); o.w = pk2(s[6 * 33] * g1[2], s[7 * 33] * g1[3]);
        if (n < ncols) *(u32x4*)(WT + (size_t)tr_rowmap(map, n) * K + k0 + 8 * c) = o; }
}
__device__ __forceinline__ void tr_store_f8(unsigned char* WT, int K, int k0, int n0, LAS float* scr, int lane) {
    const int c = lane & 3;
#pragma unroll
    for (int j = 0; j < 2; ++j) { const int nl = (lane >> 2) + 16 * j; const LAS float* s = scr + (16 * c) * 33 + nl; u32x4 o;
#pragma unroll
        for (int q = 0; q < 4; ++q) o[q] = pk4_fp8(s[(4 * q) * 33] * WSCALE, s[(4 * q + 1) * 33] * WSCALE, s[(4 * q + 2) * 33] * WSCALE, s[(4 * q + 3) * 33] * WSCALE);
        *(u32x4*)(WT + (size_t)(n0 + nl) * K + k0 + 16 * c) = o; }
}
__device__ __forceinline__ void row_to_bf16(const float* xrow, bf16_t* orow, float* rstd_out, int lane) {
    const f32x4* xr = (const f32x4*)xrow + lane;
    f32x4 v[8]; float s = 0.f;
#pragma unroll
    for (int j = 0; j < 8; ++j) { v[j] = xr[64 * j]; s += (v[j].x * v[j].x + v[j].y * v[j].y) + (v[j].z * v[j].z + v[j].w * v[j].w); }
    s = wave_sum(s);
    if (lane == 0) *rstd_out = 1.0f / sqrtf(s * (1.0f / DM) + RMS_EPS);
    u32x2* o8 = (u32x2*)orow + lane;
#pragma unroll
    for (int j = 0; j < 8; ++j) { u32x2 w; w.x = pk2(v[j].x, v[j].y); w.y = pk2(v[j].z, v[j].w); o8[64 * j] = w; }
}
constexpr int CVT_ITEMS1 = NE * 16 * 32, CVT_ITEMS2 = NE * 16 * 16, CVT_ITEMS = CVT_ITEMS1 + CVT_ITEMS2;
constexpr int BG_PACE = 2;
constexpr int CVT_P9_ITEMS = 2048;
constexpr int CVT_P9_E0 = 24;
constexpr int CVT_P4_ITEMS = 6144;
constexpr int CVT_P1_ITEMS = 3072;
constexpr int CVT_P0_ITEMS = 0;
struct CvtBuf { f32x4 v[16]; };
struct CvtDesc { const float* W; unsigned char* WT; int ldw, n0, kb0, k0, map; };
__device__ __forceinline__ CvtDesc cvt_desc(const Frame& F, int item, int sub2, int h) {
    CvtDesc d; int kblk, nblk;
    if (item < CVT_ITEMS1) { const int e = item >> 9, rem = item & 511; kblk = rem >> 5; nblk = rem & 31; d.W = F.w_mlp1 + (size_t)e * DM * 2 * DE; d.ldw = 2 * DE; d.WT = F.ws + WS_W1 + (size_t)e * 2 * DE * DM; d.map = 2; }
    else { const int it = item - CVT_ITEMS1; const int e = it >> 8, rem = it & 255; kblk = rem >> 4; nblk = rem & 15; d.W = F.w_mlp2 + (size_t)e * DE * DM; d.ldw = DM; d.WT = F.ws + WS_W2 + (size_t)e * DM * DE; d.map = 0; }
    d.n0 = nblk * 128; d.kb0 = kblk * 128; d.k0 = d.kb0 + 64 * h + 32 * sub2;
    return d;
}
__device__ __forceinline__ void cvt_load(CvtBuf& b, const CvtDesc& d, int lane) {
    const float* p = d.W + (size_t)(d.k0 + 16 * (lane >> 5)) * d.ldw + d.n0 + 4 * (lane & 31);
#pragma unroll
    for (int i = 0; i < 16; ++i) b.v[i] = __builtin_nontemporal_load((const f32x4*)(p + (size_t)i * d.ldw));
}
__device__ __forceinline__ void cvt_to_lds(const CvtBuf& b, const CvtDesc& d, LAS unsigned char* img, const LAS float* gl, int sub2, int h, int lane) {
    const int hh = lane >> 5, l5 = lane & 31;
    float gs[16];
    const bool use_g = d.map == 2;
#pragma unroll
    for (int q = 0; q < 4; ++q) { const f32x4 gv = *(const LAS f32x4*)(gl + d.k0 + 16 * hh + 4 * q);
#pragma unroll
        for (int j = 0; j < 4; ++j) gs[4 * q + j] = use_g ? gv[j] : WSCALE; }
    const int c8 = 4 * h + 2 * sub2 + hh;
#pragma unroll
    for (int j = 0; j < 4; ++j) { u32x4 o;
#pragma unroll
        for (int q = 0; q < 4; ++q) { const int i = 4 * q; o[q] = pk4_fp8(b.v[i][j] * gs[i], b.v[i + 1][j] * gs[i + 1], b.v[i + 2][j] * gs[i + 2], b.v[i + 3][j] * gs[i + 3]); }
        *(LAS u32x4*)(img + (4 * l5 + j) * 128 + 16 * (c8 ^ (l5 & 7))) = o; }
}
__device__ __forceinline__ void cvt_flush(const CvtDesc& d, LAS unsigned char* img, int h, int lane) {
#pragma unroll 4
    for (int it = 0; it < 8; ++it) { const int r = 64 * h + (lane >> 3) + 8 * it, c = lane & 7;
        const u32x4 o = *(const LAS u32x4*)(img + r * 128 + 16 * (c ^ ((r >> 2) & 7)));
        const int n = d.n0 + r; int row = n; if (d.map == 2) { const int oo = n >> 1, bj = n & 1; row = 256 * (oo >> 7) + 128 * bj + (oo & 127); }
        __builtin_nontemporal_store(o, (u32x4*)(d.WT + (size_t)row * DM + d.kb0 + 16 * c)); }
}
__device__ __forceinline__ void cvt_fill_g(const Frame& F) { LAS float* gl = (LAS float*)(F.lds + BG_G_OFF); for (int i = F.tid; i < DM; i += NTHREADS) gl[i] = F.g_moe[i] * WSCALE; __syncthreads(); }
struct Bg {
    CvtBuf buf; const Frame* F; LAS unsigned char* img; const LAS float* gl; int q, nq, pgw, npg, state, ctr, h, fitem;
    __device__ __forceinline__ void init(const Frame& F_, int first_item, int n_items) { init(F_, first_item, n_items, F_.vcu, F_.G); }
    __device__ __forceinline__ void init(const Frame& F_, int first_item, int n_items, int rank, int nranks) {
        F = &F_; img = F_.lds + BG_OFF + (F_.wave >> 1) * 16384; gl = (const LAS float*)(F_.lds + BG_G_OFF); pgw = first_item + rank * 4 + (F_.wave >> 1); npg = nranks * 4; h = F_.wave & 1;
        const int last = first_item + n_items; const int nit = pgw < last ? (last - pgw + npg - 1) / npg : 0; q = 0; nq = nit * 2; state = 0; ctr = 0; fitem = -1; }
    __device__ __forceinline__ int item_of(int qq) const { return pgw + (qq >> 1) * npg; }
    __device__ __forceinline__ CvtDesc desc(int qq) const { return cvt_desc(*F, item_of(qq), qq & 1, h); }
    __device__ __forceinline__ bool inflight() const { return state == 1; }
    __device__ __forceinline__ void proc() { cvt_to_lds(buf, desc(q), img, gl, q & 1, h, F->lane); if (q & 1) fitem = item_of(q); ++q; }
    __device__ __forceinline__ void flush() { if (fitem >= 0) { cvt_flush(cvt_desc(*F, fitem, 0, h), img, h, F->lane); fitem = -1; } }
    __device__ __forceinline__ void tick() { flush(); if (state == 2) { proc(); state = 0; } else if (state == 1) state = 2; }
    __device__ __forceinline__ void issue() { if (state == 0 && q < nq && ctr <= 0) { cvt_load(buf, desc(q), F->lane); state = 1; ctr = BG_PACE; } --ctr; }
    __device__ __forceinline__ void drain() {
        __syncthreads(); flush(); __syncthreads();
        if (state != 0) { proc(); state = 0; if (fitem >= 0) { __syncthreads(); flush(); __syncthreads(); } }
        if (q >= nq) { __syncthreads(); return; }
        CvtBuf b2;
        cvt_load(buf, desc(q), F->lane);
        while (q < nq) {
            if (q + 1 < nq) cvt_load(b2, desc(q + 1), F->lane);
            cvt_to_lds(buf, desc(q), img, gl, q & 1, h, F->lane); if (q & 1) fitem = item_of(q); ++q;
            if (fitem >= 0) { __syncthreads(); flush(); __syncthreads(); }
            if (q >= nq) break;
            if (q + 1 < nq) cvt_load(buf, desc(q + 1), F->lane);
            cvt_to_lds(b2, desc(q), img, gl, q & 1, h, F->lane); if (q & 1) fitem = item_of(q); ++q;
            if (fitem >= 0) { __syncthreads(); flush(); __syncthreads(); }
        }
    }
};
__device__ __forceinline__ void row2_to_bf16(const float* xrow, bf16_t* orow, float* rstd_out, size_t rowdist, int rdist, int lane) {
    const f32x4* xa = (const f32x4*)xrow + lane; const f32x4* xb = (const f32x4*)(xrow + rowdist) + lane;
    f32x4 va[8], vb[8]; float sa = 0.f, sb = 0.f;
#pragma unroll
    for (int j = 0; j < 8; ++j) { va[j] = xa[64 * j]; vb[j] = xb[64 * j]; }
#pragma unroll
    for (int j = 0; j < 8; ++j) { sa += (va[j].x * va[j].x + va[j].y * va[j].y) + (va[j].z * va[j].z + va[j].w * va[j].w); sb += (vb[j].x * vb[j].x + vb[j].y * vb[j].y) + (vb[j].z * vb[j].z + vb[j].w * vb[j].w); }
    sa = wave_sum(sa); sb = wave_sum(sb);
    if (lane == 0) { rstd_out[0] = 1.0f / sqrtf(sa * (1.0f / DM) + RMS_EPS); rstd_out[rdist] = 1.0f / sqrtf(sb * (1.0f / DM) + RMS_EPS); }
    u32x2* oa = (u32x2*)orow + lane; u32x2* ob = (u32x2*)(orow + rowdist) + lane;
#pragma unroll
    for (int j = 0; j < 8; ++j) { u32x2 w; w.x = pk2(va[j].x, va[j].y); w.y = pk2(va[j].z, va[j].w); oa[64 * j] = w; u32x2 w2; w2.x = pk2(vb[j].x, vb[j].y); w2.y = pk2(vb[j].z, vb[j].w); ob[64 * j] = w2; }
}
__device__ __forceinline__ void p0_prologue(Frame& F) {
    LAS float* scr = (LAS float*)(F.lds + F.wave * 16384);
    const int gw = F.vcu * NWAVES + F.wave, NGW = F.G * NWAVES;
    constexpr int I_IN = 32 * 145, I_OUT = 32 * 64, I_CQ = 32 * 16, I_CKV = 32 * 32, I_CO = 8 * 64;
    constexpr int NSMALL = I_IN + I_OUT + I_CQ + I_CKV + I_CO;
    constexpr int NITEMS = NSMALL;
    bf16_t* WIN = WSP(bf16_t, WS_WIN);
#define TR_LOAD(it_) do { int r_ = (it_); \
        if (r_ < I_IN) tr_load(va, F.w_in, IN_COLS, IN_COLS, 64 * (r_ / 145), 32 * (r_ % 145), F.lane); \
        else if ((r_ -= I_IN) < I_OUT) tr_load(va, F.w_out, DM, DM, 64 * (r_ / 64), 32 * (r_ % 64), F.lane); \
        else if ((r_ -= I_OUT) < I_CQ) tr_load(va, F.w_cq, CW, CW, 64 * (r_ / 16), 32 * (r_ % 16), F.lane); \
        else if ((r_ -= I_CQ) < I_CKV) tr_load(va, F.w_ckv, 2 * CW, 2 * CW, 64 * (r_ / 32), 32 * (r_ % 32), F.lane); \
        else { r_ -= I_CKV; tr_load(va, F.w_co, DM, DM, 64 * (r_ / 64), 32 * (r_ % 64), F.lane); } } while (0)
#define TR_STORE(it_) do { int r_ = (it_); \
        if (r_ < I_IN) tr_store(WIN, F.g_mix, IN_COLS, DM, 1, 64 * (r_ / 145), 32 * (r_ % 145), scr, F.lane); \
        else if ((r_ -= I_IN) < I_OUT) tr_store_f8(WSP(unsigned char, WS_WOUT), DM, 64 * (r_ / 64), 32 * (r_ % 64), scr, F.lane); \
        else if ((r_ -= I_OUT) < I_CQ) tr_store(WSP(bf16_t, WS_WCQ), F.g_cross, CW, DM, 0, 64 * (r_ / 16), 32 * (r_ % 16), scr, F.lane); \
        else if ((r_ -= I_CQ) < I_CKV) tr_store(WSP(bf16_t, WS_WCKV), F.g_mem, 2 * CW, DM, 0, 64 * (r_ / 32), 32 * (r_ % 32), scr, F.lane); \
        else { r_ -= I_CKV; tr_store(WSP(bf16_t, WS_WCO), nullptr, DM, CW, 0, 64 * (r_ / 64), 32 * (r_ % 64), scr, F.lane); } } while (0)
    { float va[32]; int it = gw;
      if (it < NITEMS) TR_LOAD(it);
      while (it < NITEMS) {
#pragma unroll
          for (int i = 0; i < 32; ++i) scr[(2 * i + (F.lane >> 5)) * 33 + (F.lane & 31)] = va[i];
          const int itn = it + NGW;
          if (itn < NITEMS) TR_LOAD(itn);
          LDS_WAIT(); asm volatile("" ::: "memory");
          TR_STORE(it);
          LDS_WAIT(); asm volatile("" ::: "memory");
          it = itn;
      } }
#undef TR_LOAD
#undef TR_STORE
    if (CVT_P0_ITEMS > 0) { __syncthreads(); cvt_fill_g(F); Bg bg; bg.init(F, 0, CVT_P0_ITEMS); bg.drain(); }
    { u32x4* z = (u32x4*)(WIN + (size_t)IN_COLS * DM); const int nz = (INP - IN_COLS) * DM * 2 / 16;
      for (int i = F.vcu * NTHREADS + F.tid; i < nz; i += F.G * NTHREADS) z[i] = (u32x4){0u, 0u, 0u, 0u}; }
    { u32x4* wrb = WSP(u32x4, WS_WRG);
      for (int i = F.vcu * NTHREADS + F.tid; i < 32 * 4 * 2 * 64; i += F.G * NTHREADS) {
          const int ln = i & 63, pc = (i >> 6) & 1, j = (i >> 7) & 3, c = i >> 9;
          const int k0 = 64 * c + 32 * (ln >> 5) + 8 * j, n = ln & 31;
          unsigned hw[8];
#pragma unroll
          for (int t = 0; t < 8; ++t) { const float w = F.w_router[(size_t)(k0 + t) * NE + n] * F.g_moe[k0 + t]; const unsigned hi = f2bf(w); const float rest = w - __builtin_bit_cast(float, hi << 16); hw[t] = pc ? f2bf(rest) : hi; }
          wrb[i] = (u32x4){hw[0] | (hw[1] << 16), hw[2] | (hw[3] << 16), hw[4] | (hw[5] << 16), hw[6] | (hw[7] << 16)}; } }
    for (int m = gw; m < NTOK; m += 2 * NGW) row2_to_bf16(F.x + (size_t)m * DM, WSP(bf16_t, WS_XB) + (size_t)m * DM, WSP(float, WS_RSTD0) + m, (size_t)NGW * DM, NGW, F.lane);
    for (int m = gw; m < NBATCH * NMEM; m += NGW) row_to_bf16(F.mem + (size_t)m * DM, WSP(bf16_t, WS_MEMB) + (size_t)m * DM, WSP(float, WS_RSTDM) + m, F.lane);
}

using pg8::Unit;
struct SchedP1 {
    static constexpr bool GATHER = false;
    int G, c; const char *XB, *MEMB, *WIN, *WCKV;
    __device__ __forceinline__ bool next(int i, Unit& u) const {
        int L = i * G + c;
        if (L < 64 * 19) { pg8::grid_order(L, 64, 19, u.pm, u.pn); u.e = 0; u.aux = 0; return true; }
        L -= 64 * 19; if (L < 16) { u.pm = L >> 2; u.pn = L & 3; u.e = 1; u.aux = 0; return true; }
        return false;
    }
    __device__ __forceinline__ const char* a_base(const Unit& u) const { return u.e ? MEMB : XB; }
    __device__ __forceinline__ unsigned a_off(const Unit& u, int r) const { return (unsigned)(u.pm * 256 + r) * (unsigned)(DM * 2); }
    __device__ __forceinline__ const char* b_base(const Unit& u) const { return (u.e ? WCKV : WIN) + (size_t)u.pn * 256 * DM * 2; }
};
struct SchedGrid {
    static constexpr bool GATHER = false;
    int G, c, nM, nN, K; const char *A, *B;
    __device__ __forceinline__ bool next(int i, Unit& u) const { u.e = 0; u.aux = 0; return pg8::grid_order(i * G + c, nM, nN, u.pm, u.pn); }
    __device__ __forceinline__ const char* a_base(const Unit&) const { return A; }
    __device__ __forceinline__ unsigned a_off(const Unit& u, int r) const { return (unsigned)(u.pm * 256 + r) * (unsigned)(K * 2); }
    __device__ __forceinline__ const char* b_base(const Unit& u) const { return B + (size_t)u.pn * 256 * K * 2; }
};
template <bool MLP1> struct SchedMoe {
    static constexpr bool GATHER = MLP1;
    const LAS int* tab; int G, vcu; const char *A, *W; const int* rowlist; size_t estride; int i0, Lend;
    __device__ __forceinline__ bool next(int i, Unit& u) const {
        const int L = (i0 + i) * G + vcu; if (L >= Lend) return false;
        int e = 0;
#pragma unroll
        for (int st = 16; st >= 1; st >>= 1) if (tab[e + st] <= L) e += st;
        const int rem = L - tab[e], nt = tab[66 + e];
        const int pn = rem / nt, pm = rem - pn * nt;
        u.e = __builtin_amdgcn_readfirstlane(e); u.pn = __builtin_amdgcn_readfirstlane(pn); u.pm = __builtin_amdgcn_readfirstlane(pm);
        u.aux = __builtin_amdgcn_readfirstlane((tab[33 + e] + pm) * 256);
        return true;
    }
    __device__ __forceinline__ int nrows(const Unit& u) const { const int n = tab[98 + u.e] - u.pm * 256; return n < 256 ? n : 256; }
    __device__ __forceinline__ const char* a_base(const Unit&) const { return A; }
    __device__ __forceinline__ unsigned a_off(const Unit& u, int r) const {
        if (MLP1) { int pos = u.pm * 256 + r; const int last = tab[98 + u.e] - 1; pos = pos < last ? pos : last; const int ts = rowlist[u.e * ECAP + pos]; return (unsigned)(ts >> 2) * (unsigned)DM; }
        return (unsigned)(u.aux + r) * (unsigned)DE;
    }
    __device__ __forceinline__ const char* b_base(const Unit& u) const { return W + (size_t)u.e * estride + (size_t)u.pn * 256 * DM; }
};

typedef const f32x4 (&AccRef)[2][2][4][2];
struct EpiP1 {
    static constexpr bool PERM = true;
    bf16_t *FQ, *FK, *FV, *SQ, *SK, *SV, *CKV; const float *rstd0, *rstdm, *bforget; float* logf; unsigned* kmax;
    __device__ __forceinline__ void operator()(AccRef acc, const Unit& u, int wr, int wc, int fr, int fq) const {
        if (u.e == 0 && u.pn == 18) {
            if (wc == 0 && fq < 2) {
#pragma unroll
                for (int ai = 0; ai < 2; ++ai)
#pragma unroll
                    for (int m = 0; m < 4; ++m) { const int row = u.pm * 256 + ai * 128 + wr * 64 + m * 16 + fr; const float rs = rstd0[row]; const int b = row >> 12, s = row & 4095;
#pragma unroll
                        for (int n = 0; n < 2; ++n)
#pragma unroll
                            for (int j = 0; j < 4; ++j) { const int head = 8 * fq + 4 * n + j; const float z = rs * acc[ai][0][m][n][j] + bforget[head];
                                const float lf2 = __builtin_fminf(z, 0.f) * LOG2E - __builtin_amdgcn_logf(1.0f + __builtin_amdgcn_exp2f(-fabsf(z) * LOG2E)); logf[(size_t)(b * 16 + head) * SEQ + s] = lf2; } }
            }
            return;
        }
        bf16_t* dst; int ldc, col0; float sc = 1.f; const float* rs = rstd0;
        if (u.e == 1) { dst = CKV; ldc = 2 * CW; col0 = u.pn * 256; rs = rstdm; }
        else if (u.pn < 4) { dst = FQ; ldc = 1024; col0 = u.pn * 256; sc = C2_64; }
        else if (u.pn < 8) { dst = FK; ldc = 1024; col0 = (u.pn - 4) * 256; }
        else if (u.pn < 12) { dst = FV; ldc = 1024; col0 = (u.pn - 8) * 256; }
        else if (u.pn < 16) { dst = SQ; ldc = 1024; col0 = (u.pn - 12) * 256; sc = C2_64; }
        else if (u.pn == 16) { dst = SK; ldc = 256; col0 = 0; }
        else { dst = SV; ldc = 256; col0 = 0; }
        col0 += wc * 32 + 8 * fq;
        const bool is_fk = (u.e == 0 && u.pn >= 4 && u.pn < 8);
        float mx[2] = {0.f, 0.f};
        float rsv[8];
#pragma unroll
        for (int i = 0; i < 8; ++i) rsv[i] = rs[u.pm * 256 + (i >> 2) * 128 + wr * 64 + (i & 3) * 16 + fr];
#pragma unroll
        for (int ai = 0; ai < 2; ++ai)
#pragma unroll
            for (int m = 0; m < 4; ++m) { const int row = u.pm * 256 + ai * 128 + wr * 64 + m * 16 + fr; const float f = rsv[ai * 4 + m] * sc; bf16_t* rowp = dst + (size_t)row * ldc + col0;
#pragma unroll
                for (int bj = 0; bj < 2; ++bj) { const f32x4 v0 = acc[ai][bj][m][0] * f, v1 = acc[ai][bj][m][1] * f;
                    u32x4 w; w.x = cvt_pk_bf16(v0[0], v0[1]); w.y = cvt_pk_bf16(v0[2], v0[3]); w.z = cvt_pk_bf16(v1[0], v1[1]); w.w = cvt_pk_bf16(v1[2], v1[3]);
                    *(u32x4*)(rowp + bj * 128) = w;
                    if (is_fk) { float q = (v0[0] * v0[0] + v0[1] * v0[1]) + (v0[2] * v0[2] + v0[3] * v0[3]) + (v1[0] * v1[0] + v1[1] * v1[1]) + (v1[2] * v1[2] + v1[3] * v1[3]);
                        q += __shfl_xor(q, 16); q += __shfl_xor(q, 32); mx[bj] = __builtin_fmaxf(mx[bj], q); } } }
        if (is_fk) {
#pragma unroll
            for (int bj = 0; bj < 2; ++bj) { float q = mx[bj];
#pragma unroll
                for (int o = 1; o < 16; o <<= 1) q = __builtin_fmaxf(q, __shfl_xor(q, o));
                if (fr == 0 && fq == 0) { const int b = (u.pm * 256) >> 12, head = (u.pn - 4) * 4 + 2 * bj + (wc >> 1);
                    __hip_atomic_fetch_max(kmax + (b * 16 + head) * 2 + (wc & 1), __float_as_uint(q), __ATOMIC_RELAXED, __HIP_MEMORY_SCOPE_AGENT); } }
        }
    }
};
struct EpiRes {
    static constexpr bool PERM = true;
    const float* res; const bf16_t* resb; float* outf; bf16_t* outb; float* ssq; unsigned* out8; float ascale;
    __device__ __forceinline__ void operator()(AccRef acc, const Unit& u, int wr, int wc, int fr, int fq) const {
        const int col0 = u.pn * 256 + wc * 32 + 8 * fq;
#pragma unroll
        for (int ai = 0; ai < 2; ++ai) {
            f32x4 rv[4][2][2];
#pragma unroll
            for (int m = 0; m < 4; ++m) { const size_t off = (size_t)(u.pm * 256 + ai * 128 + wr * 64 + m * 16 + fr) * DM + col0;
#pragma unroll
                for (int bj = 0; bj < 2; ++bj) {
                    if (resb) { const u32x4 w = *(const u32x4*)(resb + off + bj * 128);
                        rv[m][bj][0] = (f32x4){bf_lo(w.x), bf_hi(w.x), bf_lo(w.y), bf_hi(w.y)}; rv[m][bj][1] = (f32x4){bf_lo(w.z), bf_hi(w.z), bf_lo(w.w), bf_hi(w.w)}; }
                    else { rv[m][bj][0] = *(const f32x4*)(res + off + bj * 128); rv[m][bj][1] = *(const f32x4*)(res + off + bj * 128 + 4); } } }
#pragma unroll
            for (int m = 0; m < 4; ++m) { const int row = u.pm * 256 + ai * 128 + wr * 64 + m * 16 + fr; const size_t off = (size_t)row * DM + col0; float ss = 0.f;
#pragma unroll
                for (int bj = 0; bj < 2; ++bj) { const size_t o2 = off + bj * 128; const f32x4 v0 = rv[m][bj][0] + acc[ai][bj][m][0] * ascale, v1 = rv[m][bj][1] + acc[ai][bj][m][1] * ascale;
                    if (outf) { *(f32x4*)(outf + o2) = v0; *(f32x4*)(outf + o2 + 4) = v1; }
                    if (outb) { u32x4 w; w.x = cvt_pk_bf16(v0[0], v0[1]); w.y = cvt_pk_bf16(v0[2], v0[3]); w.z = cvt_pk_bf16(v1[0], v1[1]); w.w = cvt_pk_bf16(v1[2], v1[3]); *(u32x4*)(outb + o2) = w; }
                    if (out8) { u32x2 w8; w8.x = pk4_fp8(v0[0], v0[1], v0[2], v0[3]); w8.y = pk4_fp8(v1[0], v1[1], v1[2], v1[3]); *(u32x2*)((unsigned char*)out8 + o2) = w8; }
                    ss += (v0[0] * v0[0] + v0[1] * v0[1]) + (v0[2] * v0[2] + v0[3] * v0[3]) + (v1[0] * v1[0] + v1[1] * v1[1]) + (v1[2] * v1[2] + v1[3] * v1[3]); }
                ss += __shfl_xor(ss, 16); ss += __shfl_xor(ss, 32);
                if (fq == 0) atomicAdd(ssq + row, ss); }
        }
    }
};
struct EpiCQ {
    static constexpr bool PERM = true;
    bf16_t* CQ; const float* ssq1;
    __device__ __forceinline__ void operator()(AccRef acc, const Unit& u, int wr, int wc, int fr, int fq) const {
        const int col0 = u.pn * 256 + wc * 32 + 8 * fq;
        float sq[8];
#pragma unroll
        for (int i = 0; i < 8; ++i) sq[i] = ssq1[u.pm * 256 + (i >> 2) * 128 + wr * 64 + (i & 3) * 16 + fr];
#pragma unroll
        for (int ai = 0; ai < 2; ++ai)
#pragma unroll
            for (int m = 0; m < 4; ++m) { const int row = u.pm * 256 + ai * 128 + wr * 64 + m * 16 + fr; const float f = C2_128 / sqrtf(sq[ai * 4 + m] * (1.0f / DM) + RMS_EPS); bf16_t* rowp = CQ + (size_t)row * CW + col0;
#pragma unroll
                for (int bj = 0; bj < 2; ++bj) { const f32x4 v0 = acc[ai][bj][m][0] * f, v1 = acc[ai][bj][m][1] * f;
                    u32x4 w; w.x = cvt_pk_bf16(v0[0], v0[1]); w.y = cvt_pk_bf16(v0[2], v0[3]); w.z = cvt_pk_bf16(v1[0], v1[1]); w.w = cvt_pk_bf16(v1[2], v1[3]);
                    *(u32x4*)(rowp + bj * 128) = w; } }
    }
};
__device__ __forceinline__ f32x4 swiglu4(f32x4 ug, f32x4 ul) {
    f32x4 xg, xl, e, sg;
#pragma unroll
    for (int j = 0; j < 4; ++j) { xg[j] = __builtin_fminf(ug[j], 7.0f); xl[j] = __builtin_fminf(__builtin_fmaxf(ul[j], -7.0f), 7.0f); }
    const f32x4 t = xg * (-1.702f * LOG2E);
#pragma unroll
    for (int j = 0; j < 4; ++j) e[j] = __builtin_amdgcn_exp2f(t[j]);
    const f32x4 d = e + 1.0f;
#pragma unroll
    for (int j = 0; j < 4; ++j) sg[j] = __builtin_amdgcn_rcpf(d[j]);
    return (xg * sg) * (xl + 1.0f);
}
__device__ __forceinline__ float swiglu1(float ug, float ul) {
    const float xg = __builtin_fminf(ug, 7.0f), xl = __builtin_fminf(__builtin_fmaxf(ul, -7.0f), 7.0f);
    const float sg = __builtin_amdgcn_rcpf(1.0f + __builtin_amdgcn_exp2f(-1.702f * LOG2E * xg));
    return xg * sg * (xl + 1.0f);
}
struct EpiMlp1 {
    static constexpr bool PERM = true;
    const LAS int* tab; const int* rowlist; const float* rowrs; const float* b1; unsigned char* H;
    __device__ __forceinline__ void operator()(AccRef acc, const Unit& u, int wr, int wc, int fr, int fq) const {
        const int o0 = u.pn * 128 + wc * 32 + 8 * fq; const int cnt = tab[98 + u.e];
        f32x4 bb[4];
#pragma unroll
        for (int q = 0; q < 4; ++q) bb[q] = *(const f32x4*)(b1 + (size_t)u.e * 2 * DE + 2 * o0 + 4 * q);
        f32x4 bgv[2], blv[2];
#pragma unroll
        for (int n = 0; n < 2; ++n)
#pragma unroll
            for (int j = 0; j < 4; ++j) { const int q = 4 * n + j; bgv[n][j] = bb[q >> 1][(q & 1) * 2]; blv[n][j] = bb[q >> 1][(q & 1) * 2 + 1]; }
        float rsv[8];
#pragma unroll
        for (int i = 0; i < 8; ++i) { int pos = u.pm * 256 + (i >> 2) * 128 + wr * 64 + (i & 3) * 16 + fr; pos = pos < cnt - 1 ? pos : cnt - 1; rsv[i] = rowrs[u.e * ECAP + pos] * WSCALE_INV; }
#pragma unroll
        for (int ai = 0; ai < 2; ++ai)
#pragma unroll
            for (int m = 0; m < 4; ++m) { const int r = ai * 128 + wr * 64 + m * 16 + fr, pos = u.pm * 256 + r; const bool valid = pos < cnt;
                const float rs = rsv[ai * 4 + m];
                const f32x4 h0 = swiglu4(acc[ai][0][m][0] * rs + bgv[0], acc[ai][1][m][0] * rs + blv[0]), h1 = swiglu4(acc[ai][0][m][1] * rs + bgv[1], acc[ai][1][m][1] * rs + blv[1]);
                u32x2 w; w.x = pk4_fp8(h0[0], h0[1], h0[2], h0[3]); w.y = pk4_fp8(h1[0], h1[1], h1[2], h1[3]);
                if (valid) *(u32x2*)(H + (size_t)(u.aux + r) * DE + o0) = w; }
    }
};
struct EpiMlp2 {
    static constexpr bool PERM = true;
    const LAS int* tab; const int* rowlist; const float* rowgate; const float* b2; unsigned char* Y;
    __device__ __forceinline__ void operator()(AccRef acc, const Unit& u, int wr, int wc, int fr, int fq) const {
        const int col0 = u.pn * 256 + wc * 32 + 8 * fq; const int cnt = tab[98 + u.e];
        f32x4 bv[2][2];
#pragma unroll
        for (int bj = 0; bj < 2; ++bj)
#pragma unroll
            for (int n = 0; n < 2; ++n) bv[bj][n] = *(const f32x4*)(b2 + (size_t)u.e * DM + col0 + bj * 128 + 4 * n);
        int tsv[8]; float gtv[8];
#pragma unroll
        for (int i = 0; i < 8; ++i) { int pos = u.pm * 256 + (i >> 2) * 128 + wr * 64 + (i & 3) * 16 + fr; pos = pos < cnt - 1 ? pos : cnt - 1; tsv[i] = rowlist[u.e * ECAP + pos]; gtv[i] = rowgate[u.e * ECAP + pos]; }
#pragma unroll
        for (int ai = 0; ai < 2; ++ai)
#pragma unroll
            for (int m = 0; m < 4; ++m) { const int r = ai * 128 + wr * 64 + m * 16 + fr, pos = u.pm * 256 + r; const bool valid = pos < cnt;
                const int ts = tsv[ai * 4 + m]; const float gt = gtv[ai * 4 + m];
                unsigned char* rowp = Y + (size_t)ts * DM + col0;
#pragma unroll
                for (int bj = 0; bj < 2; ++bj) { const f32x4 v0 = (acc[ai][bj][m][0] * WSCALE_INV + bv[bj][0]) * gt, v1 = (acc[ai][bj][m][1] * WSCALE_INV + bv[bj][1]) * gt;
                    u32x2 w; w.x = pk4_fp8(v0[0], v0[1], v0[2], v0[3]); w.y = pk4_fp8(v1[0], v1[1], v1[2], v1[3]);
                    if (valid) *(u32x2*)(rowp + bj * 128) = w; } }
    }
};

__device__ __forceinline__ void moe_tables(Frame& F, int ncol) {
    LAS int* tab = (LAS int*)(F.lds + TAB_OFF);
    if (F.wave == 0) {
        const int e = F.lane & 31;
        const int c = (int)__hip_atomic_load(F.ctl + CW_CNT + e, RLX_AGENT); const int nt = (c + 255) >> 8;
        int inc = nt;
#pragma unroll
        for (int o = 1; o < 32; o <<= 1) { const int t = __shfl_up(inc, o, 32); if (e >= o) inc += t; }
        const int excl = inc - nt;
        if (F.lane < 32) { tab[e] = excl * ncol; tab[33 + e] = excl; tab[66 + e] = nt > 0 ? nt : 1; tab[98 + e] = c;
            if (e == 31) { tab[32] = inc * ncol; tab[65] = inc; } }
    }
    __syncthreads();
}

constexpr int N_PHASES = 11;
struct Args { const float* in[20]; float* out; unsigned char* ws; int ph_lo, ph_hi; };
__global__ void __launch_bounds__(NTHREADS, 2) mk_fwd(Args args) {
    extern __shared__ __attribute__((aligned(16))) unsigned char lds_raw[];
    Frame F;
    F.lds = (LAS unsigned char*)lds_raw; F.MISC = (volatile LAS unsigned*)(F.lds + MISC_OFF);
    F.tid = threadIdx.x; F.lane = F.tid & 63; F.wave = __builtin_amdgcn_readfirstlane(F.tid >> 6);
    F.G = gridDim.x; { const int bx = blockIdx.x; F.vcu = (F.G % 8 == 0) ? (bx % 8) * (F.G / 8) + bx / 8 : bx; }
    F.ws = args.ws; F.ctl = (unsigned*)(args.ws + WS_CTL); F.out = args.out;
    F.x = args.in[0]; F.mem = args.in[1]; F.g_mix = args.in[2]; F.w_in = args.in[3]; F.b_forget = args.in[4]; F.sinks = args.in[5]; F.w_out = args.in[6]; F.g_cross = args.in[7]; F.g_mem = args.in[8];
    F.w_cq = args.in[9]; F.w_ckv = args.in[10]; F.w_co = args.in[11]; F.g_moe = args.in[12]; F.w_router = args.in[13]; F.b_router = args.in[14]; F.w_mlp1 = args.in[15]; F.b_mlp1 = args.in[16];
    F.w_mlp2 = args.in[17]; F.b_mlp2 = args.in[18]; F.g_final = args.in[19];
    for (int u = F.tid; u < (LDS_BYTES - TAB_OFF) / 4; u += NTHREADS) ((LAS unsigned*)(F.lds + TAB_OFF))[u] = 0u;
    __syncthreads();
    const int lo = args.ph_lo, hi = args.ph_hi;
    XcdBarrier bar; bar.bar = (unsigned*)(F.ctl + CW_BAR); bar.x = 0; bar.st = nullptr;
    if (hi - lo > 1) bar = xcd_barrier_post((unsigned*)(F.ctl + CW_BAR), F.MISC + 8);
#define IN(k) (lo <= (k) && (k) < hi)
#define SEAM(k) do { if (IN(k) && IN((k) + 1)) xcd_barrier(bar); } while (0)
    LAS unsigned char* lds = F.lds;

    if (IN(0)) { p0_prologue(F); }
    SEAM(0);
    if (IN(1)) {
        SchedP1 S{F.G, (int)blockIdx.x, (const char*)WSP(bf16_t, WS_XB), (const char*)WSP(bf16_t, WS_MEMB), (const char*)WSP(bf16_t, WS_WIN), (const char*)WSP(bf16_t, WS_WCKV)};
        EpiP1 E{WSP(bf16_t, WS_FQ), WSP(bf16_t, WS_FK), WSP(bf16_t, WS_FV), WSP(bf16_t, WS_SQ), WSP(bf16_t, WS_SK), WSP(bf16_t, WS_SV), WSP(bf16_t, WS_CKV), WSP(float, WS_RSTD0), WSP(float, WS_RSTDM), F.b_forget, WSP(float, WS_LOGF), F.ctl + CW_KMAX};
        pg8::gemm_phase<EpiP1, SchedP1, true, true>(lds, DM, S, E);
        if (F.G == 256 && blockIdx.x >= 208) {
            cvt_fill_g(F);
            Bg bg; bg.init(F, CVT_ITEMS - CVT_P9_ITEMS - CVT_P4_ITEMS - CVT_P1_ITEMS, CVT_P1_ITEMS, (int)blockIdx.x - 208, 48); bg.drain();
        }
    }
    SEAM(1);
    if (IN(2)) {
        LAS float* cl = (LAS float*)(lds + att::C_OFF);
        LAS float* wtot = (LAS float*)(lds + att::WSF_OFF);
        cvt_fill_g(F);
        Bg bg; bg.init(F, CVT_P0_ITEMS, CVT_ITEMS - CVT_P0_ITEMS - (F.G == 256 ? CVT_P9_ITEMS + CVT_P4_ITEMS + CVT_P1_ITEMS : 0));
        LAS int* qslot = (LAS int*)(lds + att::WSF_OFF + 2048 + 128);
        int prev_bh = -1;
        const int xq0 = (int)blockIdx.x & 7;
#define Q2_PULL(dst, base, per, total0) do { __syncthreads(); if (F.tid == 0) { int r_ = (total0); \
            unsigned cv_[8]; _Pragma("unroll") for (int a_ = 0; a_ < 8; ++a_) cv_[a_] = __hip_atomic_load(F.ctl + (base) + 16 * ((xq0 + a_) & 7), RLX_AGENT);     \
            _Pragma("unroll") for (int a_ = 0; a_ < 8; ++a_) { if (r_ != (total0) || cv_[a_] >= (unsigned)(per)) continue; const int x_ = (xq0 + a_) & 7; \
                const int v_ = (int)__hip_atomic_fetch_add(F.ctl + (base) + 16 * x_, 1u, RLX_AGENT); if (v_ < (per)) r_ = x_ * (per) + v_; } \
            qslot[0] = r_; } __syncthreads(); dst = __builtin_amdgcn_readfirstlane(qslot[0]); } while (0)
        int item; Q2_PULL(item, CW_Q2, 64, 512);
        while (item < 512) {
            {
            const int bh = item >> 3, j8 = item & 7, b = bh >> 4, h = bh & 15;
            if (bh != prev_bh) {
            { int tidv = F.tid; asm volatile("" : "+v"(tidv)); const int lanev = tidv & 63;
              const float* lf = WSP(float, WS_LOGF) + (size_t)bh * SEQ + tidv * 8;
              const f32x4 a = *(const f32x4*)lf, c4 = *(const f32x4*)(lf + 4);
              float pre[8]; pre[0] = a[0]; pre[1] = pre[0] + a[1]; pre[2] = pre[1] + a[2]; pre[3] = pre[2] + a[3]; pre[4] = pre[3] + c4[0]; pre[5] = pre[4] + c4[1]; pre[6] = pre[5] + c4[2]; pre[7] = pre[6] + c4[3];
              float tot = pre[7], sc = tot;
#pragma unroll
              for (int o = 1; o < 64; o <<= 1) { const int src = lanev >= o ? lanev - o : lanev; const float t = __builtin_bit_cast(float, __builtin_amdgcn_ds_bpermute(src << 2, __builtin_bit_cast(int, sc))); if (lanev >= o) sc += t; }
              __syncthreads();
              if (lanev == 63) wtot[F.wave] = sc;
              __syncthreads();
              float woff = 0.f;
              for (int w = 0; w < F.wave; ++w) woff += wtot[w];
              const float base = woff + sc - tot;
#pragma unroll
              for (int j = 0; j < 8; ++j) cl[tidv * 8 + j] = base + pre[j];
              __syncthreads(); }
            prev_bh = bh; }
            const float kmA = sqrtf(__uint_as_float(F.ctl[CW_KMAX + bh * 2])), kmB = sqrtf(__uint_as_float(F.ctl[CW_KMAX + bh * 2 + 1]));
            for (int i = 0; i < 2; ++i) {
                const int qt = (i == 0) ? 15 - j8 : j8;
                att::Prm P;
                P.Q = WSP(bf16_t, WS_FQ) + (size_t)(b * SEQ + qt * 256) * 1024 + h * 64; P.qp = 1024;
                P.K = WSP(bf16_t, WS_FK) + (size_t)(b * SEQ) * 1024 + h * 64; P.kp = 1024;
                P.V = WSP(bf16_t, WS_FV) + (size_t)(b * SEQ) * 1024 + h * 64; P.vp = 1024;
                P.O = (bf16_t*)(WSP(unsigned char, WS_AO) + (size_t)(b * SEQ + qt * 256) * DM + h * 64); P.op = DM;
                P.q0 = qt * 256; P.kt0 = 0; P.kt1 = 4 * (qt + 1); P.nkeys = SEQ; P.window = 1 << 30; P.c = cl; P.cpos0 = 0; P.sink2 = 0.f;
                P.kmaxA = kmA; P.kmaxB = kmB;
                att::attn_unit<64, true, true, false, true, true>(P, lds, bg);
            }
            }
            Q2_PULL(item, CW_Q2, 64, 512);
        }
        Q2_PULL(item, CW_Q2 + 128, 128, 1024);
        while (item < 1024) {
            {
            const int v = item >> 2;
            const int b = v >> 6, kvh = (v >> 4) & 3, qt = v & 15;
            for (int g = item & 3; g < 4; g += 4) {
                const int hq = kvh * 4 + g;
                const float slope2 = exp2f(-0.5f * (float)(hq + 1)) * LOG2E;
                __syncthreads();
                for (int i = F.tid; i < 384; i += NTHREADS) cl[i] = -slope2 * (float)(i - 128);
                __syncthreads();
                att::Prm P;
                P.Q = WSP(bf16_t, WS_SQ) + (size_t)(b * SEQ + qt * 256) * 1024 + hq * 64; P.qp = 1024;
                P.K = WSP(bf16_t, WS_SK) + (size_t)(b * SEQ) * 256 + kvh * 64; P.kp = 256;
                P.V = WSP(bf16_t, WS_SV) + (size_t)(b * SEQ) * 256 + kvh * 64; P.vp = 256;
                P.O = (bf16_t*)(WSP(unsigned char, WS_AO) + (size_t)(b * SEQ + qt * 256) * DM + 1024 + hq * 64); P.op = DM;
                P.q0 = qt * 256; P.kt0 = qt * 4 - 2; P.kt1 = qt * 4 + 4; P.nkeys = SEQ; P.window = WINDOW; P.c = cl; P.cpos0 = qt * 256 - 128; P.sink2 = F.sinks[hq] * LOG2E; P.kmaxA = 0.f; P.kmaxB = 0.f;
                if (P.kt0 < 0) P.kt0 = 0;
                att::attn_unit<64, true, true, true, false, true>(P, lds, bg);
            }
            }
            Q2_PULL(item, CW_Q2 + 128, 128, 1024);
        }
#undef Q2_PULL
        bg.drain();
    }
    SEAM(2);
    if (IN(3)) {
        SchedGrid S{F.G, (int)blockIdx.x, 64, 8, DM / 2, (const char*)WSP(unsigned char, WS_AO), (const char*)WSP(unsigned char, WS_WOUT)};
        EpiRes E{nullptr, WSP(bf16_t, WS_XB), nullptr, WSP(bf16_t, WS_X1B), (float*)(F.ctl + CW_SSQ1), nullptr, WSCALE_INV};
        pg8::gemm_phase<EpiRes, SchedGrid, true, true, true>(lds, DM / 2, S, E);
    }
    SEAM(3);
    if (IN(4)) {
        SchedGrid S{F.G, (int)blockIdx.x, 64, 2, DM, (const char*)WSP(bf16_t, WS_X1B), (const char*)WSP(bf16_t, WS_WCQ)};
        EpiCQ E{WSP(bf16_t, WS_CQ), (const float*)(F.ctl + CW_SSQ1)};
        pg8::gemm_phase<EpiCQ, SchedGrid, true, true>(lds, DM, S, E);
        if (F.G == 256 && blockIdx.x >= 128) {
            cvt_fill_g(F);
            Bg bg; bg.init(F, CVT_ITEMS - CVT_P9_ITEMS - CVT_P4_ITEMS, CVT_P4_ITEMS, (int)blockIdx.x - 128, 128); bg.drain();
        }
        for (int i = 0; ; ++i) {
            pg8::Unit u; if (!S.next(i, u)) break;
            asm volatile("s_waitcnt vmcnt(0)" ::: "memory"); __syncthreads();
            const int b = u.pm >> 4, qt = u.pm & 15;
            for (int hh = 0; hh < 2; ++hh) { const int h = 2 * u.pn + hh;
                att::Prm P;
                P.Q = WSP(bf16_t, WS_CQ) + (size_t)(b * SEQ + qt * 256) * CW + h * CHD; P.qp = CW;
                P.K = WSP(bf16_t, WS_CKV) + (size_t)(b * NMEM) * 2 * CW + h * CHD; P.kp = 2 * CW;
                P.V = WSP(bf16_t, WS_CKV) + (size_t)(b * NMEM) * 2 * CW + CW + h * CHD; P.vp = 2 * CW;
                P.O = WSP(bf16_t, WS_CO) + (size_t)(b * SEQ + qt * 256) * CW + h * CHD; P.op = CW;
                P.q0 = 0; P.kt0 = 0; P.kt1 = NMEM / 64; P.nkeys = NMEM; P.window = 1 << 30; P.c = nullptr; P.cpos0 = 0; P.sink2 = 0.f; P.kmaxA = 0.f; P.kmaxB = 0.f;
                att::NoBg nobg; att::attn_unit<128, false, false, false, false, false>(P, lds, nobg); }
        }
    }
    SEAM(4);
    if (IN(6)) {
        SchedGrid S{F.G, (int)blockIdx.x, 64, 8, CW, (const char*)WSP(bf16_t, WS_CO), (const char*)WSP(bf16_t, WS_WCO)};
        EpiRes E{nullptr, WSP(bf16_t, WS_X1B), nullptr, WSP(bf16_t, WS_X2), (float*)(F.ctl + CW_SSQ2), WSP(unsigned, WS_X2B), 1.0f};
        pg8::gemm_phase<EpiRes, SchedGrid, true, true>(lds, CW, S, E);
    }
    SEAM(6);
    if (IN(7)) {
        const bf16_t* X2 = WSP(bf16_t, WS_X2); const u32x4* wrb = WSP(u32x4, WS_WRG);
        LAS float* part = (LAS float*)lds; LAS int* hist = (LAS int*)(lds + 34816); LAS int* basel = (LAS int*)(lds + 34816 + 128);
        for (int unit = F.vcu; unit < NTOK / 64; unit += F.G) {
            const int t0 = unit * 64, tg = F.wave & 1, kq = F.wave >> 1, kh = F.lane >> 5, e = F.lane & 31;
            const bf16_t* xg = X2 + (size_t)(t0 + 32 * tg + e) * DM + kq * 512 + 32 * kh;
            const u32x4* wp = wrb + (size_t)(kq * 8) * 512 + F.lane;
            f32x16 acc = f32x16{};
            u32x4 nx[4], nw[8];
#pragma unroll
            for (int j = 0; j < 4; ++j) nx[j] = *(const u32x4*)(xg + 8 * j);
#pragma unroll
            for (int q = 0; q < 8; ++q) nw[q] = wp[q * 64];
            for (int ch = 0; ch < 8; ++ch) {
                u32x4 cx[4], cw[8];
#pragma unroll
                for (int j = 0; j < 4; ++j) cx[j] = nx[j];
#pragma unroll
                for (int q = 0; q < 8; ++q) cw[q] = nw[q];
                if (ch + 1 < 8) {
#pragma unroll
                    for (int j = 0; j < 4; ++j) nx[j] = *(const u32x4*)(xg + (ch + 1) * 64 + 8 * j);
#pragma unroll
                    for (int q = 0; q < 8; ++q) nw[q] = wp[(size_t)(ch + 1) * 512 + q * 64]; }
#pragma unroll
                for (int j = 0; j < 4; ++j) {
                    acc = __builtin_amdgcn_mfma_f32_32x32x16_bf16(__builtin_bit_cast(bf16x8, cx[j]), __builtin_bit_cast(bf16x8, cw[2 * j]), acc, 0, 0, 0);
                    acc = __builtin_amdgcn_mfma_f32_32x32x16_bf16(__builtin_bit_cast(bf16x8, cx[j]), __builtin_bit_cast(bf16x8, cw[2 * j + 1]), acc, 0, 0, 0);
                }
            }
            if (F.tid < 32) hist[F.tid] = 0;
#pragma unroll
            for (int r = 0; r < 16; ++r) part[(kq * 64 + 32 * tg + att::crow(r, kh)) * 33 + e] = acc[r];
            __syncthreads();
            if (F.wave == 0) {
                const int t = t0 + F.lane;
                const float rs = 1.0f / sqrtf(((const float*)(F.ctl + CW_SSQ2))[t] * (1.0f / DM) + RMS_EPS);
                float lg[32];
#pragma unroll
                for (int j = 0; j < 32; ++j) lg[j] = rs * ((part[(0 * 64 + F.lane) * 33 + j] + part[(1 * 64 + F.lane) * 33 + j]) + (part[(2 * 64 + F.lane) * 33 + j] + part[(3 * 64 + F.lane) * 33 + j])) + F.b_router[j];
                float tv[4]; int ti[4];
#pragma unroll
                for (int k = 0; k < 4; ++k) { float best = -INFINITY; int bi = 0;
#pragma unroll
                    for (int j = 0; j < 32; ++j) if (lg[j] > best) { best = lg[j]; bi = j; }
#pragma unroll
                    for (int j = 0; j < 32; ++j) if (j == bi) lg[j] = -INFINITY;
                    tv[k] = best; ti[k] = bi; }
                float ge[4], gs = 0.f;
#pragma unroll
                for (int k = 0; k < 4; ++k) { ge[k] = __expf(tv[k] - tv[0]); gs += ge[k]; }
                const float gi = 1.0f / gs;
                int rk[4];
#pragma unroll
                for (int k = 0; k < 4; ++k) rk[k] = __hip_atomic_fetch_add(&hist[ti[k]], 1, __ATOMIC_RELAXED, __HIP_MEMORY_SCOPE_WORKGROUP);
                LDS_WAIT();
                if (F.lane < 32) { const int hc = hist[F.lane]; int bs = 0; if (hc > 0) bs = (int)__hip_atomic_fetch_add(F.ctl + CW_CNT + F.lane, (unsigned)hc, RLX_AGENT); basel[F.lane] = bs; }
                LDS_WAIT();
                int* rowlist = WSP(int, WS_ROWLIST); float* rowgate = WSP(float, WS_ROWGATE); float* rowrs = WSP(float, WS_ROWRS);
#pragma unroll
                for (int k = 0; k < 4; ++k) { const int pos = basel[ti[k]] + rk[k]; rowlist[ti[k] * ECAP + pos] = t * 4 + k; rowgate[ti[k] * ECAP + pos] = ge[k] * gi; rowrs[ti[k] * ECAP + pos] = rs; }
                WSP(float, WS_RSTD2)[t] = rs;
            }
            __syncthreads();
        }
    }
    SEAM(7);
    if (IN(8)) {
        moe_tables(F, 16);
        const LAS int* tab = (const LAS int*)(lds + TAB_OFF);
        SchedMoe<true> S{tab, F.G, F.vcu, (const char*)WSP(unsigned char, WS_X2B), (const char*)WSP(unsigned char, WS_W1), WSP(int, WS_ROWLIST), (size_t)2 * DE * DM, 0, tab[32]};
        EpiMlp1 E{tab, WSP(int, WS_ROWLIST), WSP(float, WS_ROWRS), F.b_mlp1, WSP(unsigned char, WS_H)};
        pg8::gemm_phase<EpiMlp1, SchedMoe<true>, true, true, true>(lds, DM / 2, S, E);
    }
    SEAM(8);
    if (IN(9)) {
        moe_tables(F, 8);
        const LAS int* tab = (const LAS int*)(lds + TAB_OFF);
        SchedMoe<false> S{tab, F.G, F.vcu, (const char*)WSP(unsigned char, WS_H), (const char*)WSP(unsigned char, WS_W2), WSP(int, WS_ROWLIST), (size_t)DM * DE, 0, tab[32]};
        EpiMlp2 E{tab, WSP(int, WS_ROWLIST), WSP(float, WS_ROWGATE), F.b_mlp2, WSP(unsigned char, WS_Y)};
        const int total = tab[32], split = tab[CVT_P9_E0];
        int nparts = 1, nconv = 0;
        if (F.G == 256) {
            const int rem = total & 255; int first = rem; nconv = 256 - rem;
            if (nconv < 64) { first = 0; nconv = 256; }
            nparts = 2;
            if (F.vcu >= first) {
                Bg bg; bg.init(F, CVT_ITEMS - CVT_P9_ITEMS, CVT_P9_ITEMS, F.vcu - first, nconv); bg.drain();
                VM_WAIT(); __syncthreads();
                if (F.tid == 0) { __builtin_amdgcn_fence(__ATOMIC_RELEASE, "agent"); VM_WAIT(); (void)xb_add((unsigned*)(F.ctl + CW_CVT9), 1u); }
            }
        }
        for (int part = 0; part < nparts; ++part) {
            if (nparts == 2) {
                if (part == 0) { S.i0 = 0; S.Lend = split; }
                else {
                    if (F.tid == 0) { unsigned* bw = (unsigned*)(F.ctl + CW_BAR); XB_SPIN(xb_ld((unsigned*)(F.ctl + CW_CVT9)) < (unsigned)nconv, bw); __builtin_amdgcn_fence(__ATOMIC_ACQUIRE, "agent"); VM_WAIT(); }
                    __syncthreads();
                    S.i0 = F.vcu < split ? (split - F.vcu + F.G - 1) / F.G : 0; S.Lend = total;
                }
            }
            pg8::gemm_phase<EpiMlp2, SchedMoe<false>, true, true, true>(lds, DE / 2, S, E);
        }
    }
    SEAM(9);
    if (IN(10)) {
        const int gw = F.vcu * NWAVES + F.wave, NGW = F.G * NWAVES;
        const bf16_t* X2 = WSP(bf16_t, WS_X2); const unsigned char* Y = WSP(unsigned char, WS_Y);
        f32x4 gfin[4][2];
#pragma unroll
        for (int j = 0; j < 4; ++j)
#pragma unroll
            for (int h = 0; h < 2; ++h) gfin[j][h] = *(const f32x4*)(F.g_final + 8 * F.lane + 512 * j + 4 * h);
        for (int m = gw; m < NTOK; m += NGW) {
            const bf16_t* xr = X2 + (size_t)m * DM + 8 * F.lane;
            f32x4 v[4][2]; float s = 0.f; u32x4 xw[4];
#pragma unroll
            for (int j = 0; j < 4; ++j) xw[j] = *(const u32x4*)(xr + 512 * j);
            u32x2 yw[4][4];
#pragma unroll
            for (int k = 0; k < 4; ++k)
#pragma unroll
                for (int j = 0; j < 4; ++j) yw[k][j] = *(const u32x2*)(Y + (size_t)(m * 4 + k) * DM + 8 * F.lane + 512 * j);
#pragma unroll
            for (int j = 0; j < 4; ++j) { v[j][0] = (f32x4){bf_lo(xw[j].x), bf_hi(xw[j].x), bf_lo(xw[j].y), bf_hi(xw[j].y)}; v[j][1] = (f32x4){bf_lo(xw[j].z), bf_hi(xw[j].z), bf_lo(xw[j].w), bf_hi(xw[j].w)}; }
#pragma unroll
            for (int k = 0; k < 4; ++k)
#pragma unroll
                for (int j = 0; j < 4; ++j) { const f32x2 a = __builtin_amdgcn_cvt_pk_f32_fp8((int)yw[k][j].x, false), b2 = __builtin_amdgcn_cvt_pk_f32_fp8((int)yw[k][j].x, true),
                        c = __builtin_amdgcn_cvt_pk_f32_fp8((int)yw[k][j].y, false), d = __builtin_amdgcn_cvt_pk_f32_fp8((int)yw[k][j].y, true);
                    v[j][0] += (f32x4){a.x, a.y, b2.x, b2.y}; v[j][1] += (f32x4){c.x, c.y, d.x, d.y}; }
#pragma unroll
            for (int j = 0; j < 4; ++j)
#pragma unroll
                for (int h = 0; h < 2; ++h) s += (v[j][h].x * v[j][h].x + v[j][h].y * v[j][h].y) + (v[j][h].z * v[j][h].z + v[j][h].w * v[j][h].w);
            s = wave_sum(s);
            const float rstd = 1.0f / sqrtf(s * (1.0f / DM) + RMS_EPS);
            float* orow = F.out + (size_t)m * DM + 8 * F.lane;
#pragma unroll
            for (int j = 0; j < 4; ++j)
#pragma unroll
                for (int h = 0; h < 2; ++h) *(f32x4*)(orow + 512 * j + 4 * h) = v[j][h] * rstd * gfin[j][h];
        }
    }
#undef IN
#undef SEAM
}

extern "C" void kernel_launch(void* const* d_in, const int* in_sizes, int n_in, void* d_out, int out_size, void* d_ws, size_t ws_size, hipStream_t stream) {
    static int grid = 0;
    if (grid == 0) {
        if (n_in != 20 || in_sizes[0] != NTOK * DM || out_size != NTOK * DM || ws_size < WS_END) { fprintf(stderr, "kernel_launch: unexpected shapes (n_in %d, in0 %d, out %d, ws %zu)\n", n_in, n_in > 0 ? in_sizes[0] : -1, out_size, ws_size); grid = -1; return; }
        int dev = 0, cus = 0, per_cu = 0;
        if (hipGetDevice(&dev) != hipSuccess || hipDeviceGetAttribute(&cus, hipDeviceAttributeMultiprocessorCount, dev) != hipSuccess) { grid = -1; return; }
        if (hipFuncSetAttribute((const void*)mk_fwd, hipFuncAttributeMaxDynamicSharedMemorySize, LDS_BYTES) != hipSuccess) { fprintf(stderr, "kernel_launch: hipFuncSetAttribute failed\n"); grid = -1; return; }
        if (hipOccupancyMaxActiveBlocksPerMultiprocessor(&per_cu, (const void*)mk_fwd, NTHREADS, LDS_BYTES) != hipSuccess || per_cu < 1) fprintf(stderr, "kernel_launch: occupancy query says %d\n", per_cu);
        (void)hipGetLastError();
        grid = cus;
    }
    if (grid < 0) return;
    if (hipMemsetAsync((char*)d_ws + WS_CTL, 0, CTL_ZERO_BYTES, stream) != hipSuccess) return;
    Args a{};
    for (int i = 0; i < 20; ++i) a.in[i] = (const float*)d_in[i];
    a.out = (float*)d_out; a.ws = (unsigned char*)d_ws;
#if MK_ONE_LAUNCH
    a.ph_lo = 0; a.ph_hi = N_PHASES;
    hipLaunchKernelGGL(mk_fwd, dim3(grid), dim3(NTHREADS), LDS_BYTES, stream, a);
#else
    for (int p = 0; p < N_PHASES; ++p) { a.ph_lo = p; a.ph_hi = p + 1; hipLaunchKernelGGL(mk_fwd, dim3(grid), dim3(NTHREADS), LDS_BYTES, stream, a); }
#endif
    const hipError_t le = hipPeekAtLastError();
    if (le != hipSuccess) fprintf(stderr, "kernel_launch: launch failed: %s\n", hipGetErrorName(le));
}
```

```cpp
#include <hip/hip_runtime.h>
#include <cstdio>
#include <cstdint>

#ifndef MK_ONE_LAUNCH
#define MK_ONE_LAUNCH 1
#endif

#define LAS __attribute__((address_space(3)))
#define GAS __attribute__((address_space(1)))
typedef unsigned short bf16_t;
typedef short bf16x8 __attribute__((ext_vector_type(8)));
typedef short s16x4 __attribute__((ext_vector_type(4)));
typedef float f32x4 __attribute__((ext_vector_type(4)));
typedef float f32x2 __attribute__((ext_vector_type(2)));
typedef float f32x16 __attribute__((ext_vector_type(16)));
typedef unsigned u32x4 __attribute__((ext_vector_type(4)));
typedef unsigned u32x2 __attribute__((ext_vector_type(2)));
typedef int i32x4 __attribute__((ext_vector_type(4)));
typedef int i32x8 __attribute__((ext_vector_type(8)));

constexpr int DM = 2048, NBATCH = 4, SEQ = 4096, NTOK = NBATCH * SEQ;
constexpr int HD = 64, NFOX = 16, NSWA = 16, NSKV = 4, WINDOW = 128;
constexpr int NMEM = 256, NCH = 4, CHD = 128, CW = NCH * CHD;
constexpr int NE = 32, TOPK = 4, DE = 2048;
constexpr int IN_COLS = 4624, INP = 4864;
constexpr float RMS_EPS = 1e-5f;
constexpr float LOG2E = 1.4426950408889634f;
constexpr float C2_64 = 0.125f * LOG2E;
constexpr float C2_128 = 0.08838834764831845f * LOG2E;
constexpr int ECAP = NTOK;
constexpr float WSCALE = 64.0f, WSCALE_INV = 1.0f / 64.0f;

constexpr size_t MiB = 1u << 20;
constexpr size_t WS_CTL = 0, CTL_ZERO_BYTES = 1 * MiB;
constexpr size_t WS_WIN = 2 * MiB, WS_WOUT = 22 * MiB, WS_WCQ = 30 * MiB, WS_WCKV = 32 * MiB, WS_WCO = 36 * MiB, WS_MEMB = 38 * MiB;
constexpr size_t WS_RSTD0 = 42 * MiB, WS_RSTDM = 42 * MiB + 65536, WS_WRG = 42 * MiB + 131072  , WS_LOGF = 43 * MiB, WS_RSTD2 = 44 * MiB;
constexpr size_t WS_ROWLIST = 45 * MiB, WS_ROWGATE = 47 * MiB, WS_CKV = 50 * MiB, WS_ROWRS = 52 * MiB;
constexpr size_t WS_XB = 64 * MiB, WS_FQ = 128 * MiB, WS_FK = 160 * MiB, WS_FV = 192 * MiB, WS_SQ = 224 * MiB, WS_SK = 256 * MiB, WS_SV = 264 * MiB;
constexpr size_t WS_AO = 288 * MiB, WS_X1 = 352 * MiB, WS_X1B = 480 * MiB, WS_CQ = 544 * MiB, WS_CO = 560 * MiB, WS_X2 = 576 * MiB, WS_X2B = 704 * MiB;
constexpr size_t WS_W1 = 768 * MiB, WS_W2 = 1280 * MiB, WS_H = 1536 * MiB, WS_Y = 1824 * MiB, WS_END = 2080 * MiB;
constexpr int CW_TMO = 0, CW_CODE = 1, CW_BAR = 4096, CW_CNT = 8192, CW_KMAX = 8320  , CW_Q2 = 8512  , CW_CVT9 = 12288  , CW_SSQ1 = 16384, CW_SSQ2 = 32768;

constexpr int RING_BYTES = 131072;
constexpr int BG_G_OFF = 49152;
constexpr int BG_OFF = 90112;
constexpr int TAB_OFF = 161792;
constexpr int MISC_OFF = TAB_OFF + 1024;
constexpr int LDS_BYTES = 163840;
constexpr int NWAVES = 8, NTHREADS = 512;

#define RLX_AGENT __ATOMIC_RELAXED, __HIP_MEMORY_SCOPE_AGENT
#define LDS_WAIT() asm volatile("s_waitcnt lgkmcnt(0)" ::: "memory")
#define VM_WAIT() asm volatile("s_waitcnt vmcnt(0)" ::: "memory")
__device__ __forceinline__ unsigned f2bf(float f) { unsigned u = __builtin_bit_cast(unsigned, f); return (u + 0x7fffu + ((u >> 16) & 1u)) >> 16; }
__device__ __forceinline__ unsigned pk2(float lo, float hi) { return f2bf(lo) | (f2bf(hi) << 16); }
__device__ __forceinline__ unsigned cvt_pk_bf16(float lo, float hi) { unsigned r; asm volatile("v_cvt_pk_bf16_f32 %0, %1, %2" : "=v"(r) : "v"(lo), "v"(hi)); return r; }
__device__ __forceinline__ unsigned pk4_fp8(float a, float b, float c, float d) { int w = __builtin_amdgcn_cvt_pk_fp8_f32(a, b, 0, false); w = __builtin_amdgcn_cvt_pk_fp8_f32(c, d, w, true); return (unsigned)w; }
__device__ __forceinline__ float bf_lo(unsigned w) { return __builtin_bit_cast(float, w << 16); }
__device__ __forceinline__ float bf_hi(unsigned w) { return __builtin_bit_cast(float, w & 0xffff0000u); }
__device__ __forceinline__ float wave_sum(float v) {
#pragma unroll
    for (int o = 1; o < 64; o <<= 1) v += __shfl_xor(v, o);
    return v;
}

#define XB_TMO      128
#define XB_XCNT(j)  (256  + 64 * (j))
#define XB_XSUB(j)  (1280 + 64 * (j))
#define XB_XGEN(j)  (2304 + 64 * (j))
#define XB_TOP      3328
#define XB_TOPGEN   3392
#define XCD_BAR_WORDS 3456
#define XB_SPIN_CAP (1u << 18)
__device__ __forceinline__ unsigned xb_ld(unsigned* p)              { return __hip_atomic_load(p, __ATOMIC_RELAXED, __HIP_MEMORY_SCOPE_AGENT); }
__device__ __forceinline__ unsigned xb_add(unsigned* p, unsigned v) { return __hip_atomic_fetch_add(p, v, __ATOMIC_RELAXED, __HIP_MEMORY_SCOPE_AGENT); }
__device__ __forceinline__ unsigned xb_xcc_id() { return (unsigned)__builtin_amdgcn_s_getreg((3 << 11) | 20) & 0xFu; }
#define XB_SPIN(cond, bar) do { unsigned _sp = 0; while (cond) { __builtin_amdgcn_s_sleep(1); \
    if ((++_sp & 255u) == 0u) { if (xb_ld(&(bar)[XB_TMO])) break; if (_sp > XB_SPIN_CAP) { atomicAdd(&(bar)[XB_TMO], 1u); break; } } } } while (0)
struct XcdBarrier { unsigned* bar; unsigned x; volatile LAS unsigned* st; };
__device__ __forceinline__ XcdBarrier xcd_barrier_post(unsigned* bar, volatile LAS unsigned* st) {
    XcdBarrier b; b.bar = bar; b.x = xb_xcc_id(); b.st = st;
    if (threadIdx.x == 0) (void)xb_add(&bar[XB_XCNT(b.x)], 1u);
    return b;
}
__device__ __forceinline__ void xcd_barrier_complete(unsigned* bar, unsigned x, unsigned& nloc, unsigned& nx) {
    const unsigned G = gridDim.x * gridDim.y * gridDim.z;
    unsigned sum, cnt, mine, sp = 0u;
    for (;;) {
        sum = 0u; cnt = 0u; mine = 0u;
#pragma unroll
        for (unsigned j = 0; j < 16; ++j) { const unsigned c = xb_ld(&bar[XB_XCNT(j)]); sum += c; cnt += (c > 0u) ? 1u : 0u; mine = (j == x) ? c : mine; }
        if (sum == G) break;
        __builtin_amdgcn_s_sleep(1);
        if ((++sp & 255u) == 0u) { if (xb_ld(&bar[XB_TMO])) break; if (sp > XB_SPIN_CAP) { atomicAdd(&bar[XB_TMO], 1u); break; } }
    }
    nloc = mine > 0u ? mine : 1u; nx = cnt > 0u ? cnt : 1u;
}
__device__ __forceinline__ void xcd_barrier(const XcdBarrier& b) {
    asm volatile("s_waitcnt vmcnt(0)" ::: "memory");
    __syncthreads();
    if (threadIdx.x == 0) {
        unsigned* bar = b.bar;
        __builtin_amdgcn_s_waitcnt(0);
        unsigned nloc = b.st[0], nx = b.st[1];
        if (nloc == 0u) { xcd_barrier_complete(bar, b.x, nloc, nx); b.st[0] = nloc; b.st[1] = nx; }
        const unsigned old = xb_add(&bar[XB_XSUB(b.x)], 1u);
        const unsigned gen = old / nloc;
        if (old + 1u == (gen + 1u) * nloc) {
            __builtin_amdgcn_fence(__ATOMIC_RELEASE, "agent");
            asm volatile("s_waitcnt vmcnt(0)" ::: "memory");
            const unsigned og = xb_add(&bar[XB_TOP], 1u);
            const unsigned tg = og / nx;
            if (og + 1u == (tg + 1u) * nx) xb_add(&bar[XB_TOPGEN], 1u);
            else XB_SPIN(xb_ld(&bar[XB_TOPGEN]) == tg, bar);
            __builtin_amdgcn_fence(__ATOMIC_ACQUIRE, "agent");
            xb_add(&bar[XB_XGEN(b.x)], 1u);
            asm volatile("s_waitcnt vmcnt(0)" ::: "memory");
        } else {
            XB_SPIN(xb_ld(&bar[XB_XGEN(b.x)]) == gen, bar);
            __builtin_amdgcn_fence(__ATOMIC_ACQUIRE, "agent");
            asm volatile("s_waitcnt vmcnt(0)" ::: "memory");
        }
    }
    __syncthreads();
}

namespace pg8 {
constexpr int BM = 256, BK = 64, HALF = 128, HTB = HALF * BK * 2, STAGE_BYTES = 8 * HTB, NXCD = 8, WGM = 8;
__host__ __device__ __forceinline__ int lds_byte(int r, int c) { const int st = (r >> 4) * 2 + (c >> 5), rr = r & 15, cc = c & 31, ob = rr * 64 + cc * 2; return st * 1024 + (ob ^ (((ob >> 9) & 1) << 5)); }
__host__ __device__ __forceinline__ void stage_rc(int b, int& R, int& C) { const int st = b / 1024, sb = b % 1024, swz = sb ^ (((sb >> 9) & 1) << 5); R = (st >> 1) * 16 + swz / 64; C = (st & 1) * 32 + (swz % 64) / 2; }
__host__ __device__ __forceinline__ int perm32(int rho) { const int n = rho >> 4, i = rho & 15; return 8 * (i >> 2) + 4 * n + (i & 3); }

struct Unit { int pm, pn, e, aux; };

__device__ __forceinline__ bool grid_order(int L, int nM, int nN, int& pm, int& pn) {
    const int nwg = nM * nN; if (L >= nwg) return false;
    int wgid = L; { const int q = nwg / NXCD, r = nwg % NXCD, xcd = wgid % NXCD, off = wgid / NXCD; wgid = (xcd < r ? xcd * (q + 1) : r * (q + 1) + (xcd - r) * q) + off; }
    const int nig = WGM * nN, gid = wgid / nig, fm = gid * WGM, gsz = (nM - fm) < WGM ? (nM - fm) : WGM;
    pm = fm + ((wgid % nig) % gsz); pn = (wgid % nig) / gsz; return true;
}

template <class Epi, class Sched, bool ALIGN_EPI, bool SP2, bool FP8 = false>
__device__ __forceinline__ void gemm_phase(LAS unsigned char* lds, const int K, const Sched& S, const Epi& E) {
    const int tid = threadIdx.x, wid = __builtin_amdgcn_readfirstlane(tid >> 6), lane = tid & 63, wr = wid >> 2, wc = wid & 3, fr = lane & 15, fq = lane >> 4;
    const int nt = K / BK;
    unsigned voffB[2];
#pragma unroll
    for (int i = 0; i < 2; ++i) { int R, C; stage_rc(tid * 16 + i * 8192, R, C); const int Rb = Epi::PERM ? ((R & ~31) + perm32(R & 31)) : R;
        voffB[i] = (unsigned)(Rb * K + C) * 2u; }
    const size_t kstep = (size_t)(BK * 2);
    const size_t hstep = (size_t)HALF * K * 2;
    const unsigned ldsw = (unsigned)wid * 1024u;
    const int aoff = lds_byte(wr * 64 + fr, fq * 8), boff = lds_byte(wc * 32 + fr, fq * 8);
#define PG8_SA(b, h) (((b) * 2 + (h)) * HTB)
#define PG8_SB(b, h) ((4 + (b) * 2 + (h)) * HTB)
#define PG8_STAGE(bufoff, gbase, voff) do { _Pragma("unroll") for (int _i = 0; _i < 2; ++_i) \
        __builtin_amdgcn_global_load_lds((const unsigned*)((const char*)(gbase) + (voff)[_i]), (LAS unsigned*)(lds + (bufoff) + ldsw + _i * 8192), 16, 0, 0); } while (0)
#define PG8_LD8(p) __builtin_shufflevector(*(const LAS i32x4*)(p), *(const LAS i32x4*)((p) + 1024), 0, 1, 2, 3, 4, 5, 6, 7)
#define PG8_LDA(dst, b, h) do { if constexpr (FP8) { _Pragma("unroll") for (int m = 0; m < 4; ++m) dst##8[m] = PG8_LD8(lds + PG8_SA(b, h) + aoff + m * 2048); } \
        else { _Pragma("unroll") for (int m = 0; m < 4; ++m) _Pragma("unroll") for (int k = 0; k < 2; ++k) dst[m][k] = *(const LAS bf16x8*)(lds + PG8_SA(b, h) + aoff + m * 2048 + k * 1024); } } while (0)
#define PG8_LDB(dst, b, h) do { if constexpr (FP8) { _Pragma("unroll") for (int n = 0; n < 2; ++n) dst##8[n] = PG8_LD8(lds + PG8_SB(b, h) + boff + n * 2048); } \
        else { _Pragma("unroll") for (int n = 0; n < 2; ++n) _Pragma("unroll") for (int k = 0; k < 2; ++k) dst[n][k] = *(const LAS bf16x8*)(lds + PG8_SB(b, h) + boff + n * 2048 + k * 1024); } } while (0)
#define PG8_MMA(ai, bj, At, Bt) do { __builtin_amdgcn_s_setprio(1); \
        if constexpr (FP8) { _Pragma("unroll") for (int m = 0; m < 4; ++m) _Pragma("unroll") for (int n = 0; n < 2; ++n) \
            asm("v_mfma_f32_16x16x128_f8f6f4 %0, %1, %2, %0" : "+v"(acc[ai][bj][m][n]) : "v"(Bt##8[n]), "v"(At##8[m])); } \
        else { _Pragma("unroll") for (int m = 0; m < 4; ++m) _Pragma("unroll") for (int n = 0; n < 2; ++n) _Pragma("unroll") for (int k = 0; k < 2; ++k) \
            acc[ai][bj][m][n] = __builtin_amdgcn_mfma_f32_16x16x32_bf16(Bt[n][k], At[m][k], acc[ai][bj][m][n], 0, 0, 0); } \
        __builtin_amdgcn_s_setprio(0); } while (0)
#define PG8_WAIT_V(n) asm volatile("s_waitcnt vmcnt(" #n ")" ::: "memory")
#define PG8_WAIT_L(n) asm volatile("s_waitcnt lgkmcnt(" #n ")" ::: "memory")
#define PG8_BAR __builtin_amdgcn_s_barrier()
#define PG8_SCHED __builtin_amdgcn_sched_barrier(0)
#define PG8_AOFF(dst, u) do { int _t = tid; asm volatile("" : "+v"(_t)); _Pragma("unroll") for (int _i = 0; _i < 2; ++_i) { int _R, _C; stage_rc(_t * 16 + _i * 8192, _R, _C); \
        _Pragma("unroll") for (int _h = 0; _h < 2; ++_h) dst[_h][_i] = S.a_off(u, _h * HALF + _R) + (unsigned)_C * 2u; } \
        if (Sched::GATHER) { asm volatile("s_waitcnt vmcnt(0)" ::: "memory"); } } while (0)
#define PG8_ARAW(dst, u) do { int _t = tid; asm volatile("" : "+v"(_t)); _Pragma("unroll") for (int _i = 0; _i < 2; ++_i) { int _R, _C; stage_rc(_t * 16 + _i * 8192, _R, _C); \
        _Pragma("unroll") for (int _h = 0; _h < 2; ++_h) dst[_h][_i] = S.a_raw(u, _h * HALF + _R); } } while (0)
#define PG8_AFIN(dst, raw) do { int _t = tid; asm volatile("" : "+v"(_t)); _Pragma("unroll") for (int _i = 0; _i < 2; ++_i) { int _R, _C; stage_rc(_t * 16 + _i * 8192, _R, _C); \
        _Pragma("unroll") for (int _h = 0; _h < 2; ++_h) dst[_h][_i] = S.a_fin(raw[_h][_i]) + (unsigned)_C * 2u; } } while (0)
    Unit cur, nxt, nn; int ui = 0;
    if (!S.next(0, cur)) return;
    f32x4 acc[2][2][4][2];
#pragma unroll
    for (int a = 0; a < 2; ++a)
#pragma unroll
        for (int b = 0; b < 2; ++b)
#pragma unroll
            for (int m = 0; m < 4; ++m)
#pragma unroll
                for (int n = 0; n < 2; ++n) acc[a][b][m][n] = (f32x4){0.f, 0.f, 0.f, 0.f};
    bf16x8 At[4][2], B0[2][2], B1[2][2]; i32x8 At8[4], B08[2], B18[2];
    unsigned vAc[2][2], vAn[2][2]; int rawN[2][2]; bool g_next = false, g_nn = false;
    if constexpr (Sched::GATHER) {
        g_next = S.next(1, nxt);
        if (g_next) PG8_AOFF(vAn, nxt);
    }
    PG8_AOFF(vAc, cur);
    if constexpr (Sched::GATHER) { if (!g_next) {
#pragma unroll
        for (int h = 0; h < 2; ++h)
#pragma unroll
            for (int i = 0; i < 2; ++i) { vAn[h][i] = vAc[h][i]; } }
#pragma unroll
        for (int h = 0; h < 2; ++h)
#pragma unroll
            for (int i = 0; i < 2; ++i) rawN[h][i] = 0; }
    const char* cA = S.a_base(cur); const char* cB = S.b_base(cur);
    static_assert(SP2, "only the SP2 loop is kept");
    PG8_STAGE(PG8_SB(0, 0), cB, voffB); PG8_STAGE(PG8_SB(0, 1), cB + hstep, voffB); PG8_STAGE(PG8_SA(0, 0), cA, vAc[0]); PG8_STAGE(PG8_SA(0, 1), cA, vAc[1]);
    if (wr == 1) PG8_BAR;
    PG8_WAIT_V(2); PG8_BAR;
    PG8_STAGE(PG8_SB(1, 0), cB + kstep, voffB); PG8_STAGE(PG8_SA(1, 0), cA + kstep, vAc[0]); PG8_STAGE(PG8_SB(1, 1), cB + hstep + kstep, voffB);
    PG8_WAIT_V(6); PG8_BAR;
    for (;;) {
        bool has_next;
        const char* nA = cA; const char* nB = cB;
        if constexpr (Sched::GATHER) {
            has_next = g_next;
            if (has_next) { nA = S.a_base(nxt); nB = S.b_base(nxt); }
            g_nn = has_next && S.next(ui + 2, nn);
            if (g_nn) PG8_ARAW(rawN, nn);
        } else {
            has_next = S.next(ui + 1, nxt);
            if (has_next) { nA = S.a_base(nxt); nB = S.b_base(nxt); PG8_AOFF(vAn, nxt); }
            else {
#pragma unroll
                for (int h = 0; h < 2; ++h)
#pragma unroll
                    for (int i = 0; i < 2; ++i) vAn[h][i] = vAc[h][i];
            }
        }
        for (int t = 0; t < nt; t += 2) {
            const bool last = (t == nt - 2);
            const char* a1 = cA + (size_t)(t + 1) * kstep;
            const char* a2 = last ? nA : cA + (size_t)(t + 2) * kstep; const char* b2 = last ? nB : cB + (size_t)(t + 2) * kstep;
            const char* a3 = a2 + kstep; const char* b3 = b2 + kstep;
            unsigned vX0[2], vX1[2];
#pragma unroll
            for (int i = 0; i < 2; ++i) { vX0[i] = last ? vAn[0][i] : vAc[0][i]; vX1[i] = last ? vAn[1][i] : vAc[1][i]; }
            PG8_LDB(B0, 0, 0); PG8_LDB(B1, 0, 1); PG8_SCHED; PG8_LDA(At, 0, 0); PG8_STAGE(PG8_SA(1, 1), a1, vAc[1]);
            PG8_WAIT_V(8); PG8_WAIT_L(0); PG8_BAR; PG8_MMA(0, 0, At, B0); PG8_MMA(0, 1, At, B1); PG8_BAR; PG8_SCHED;
            PG8_LDA(At, 0, 1); PG8_STAGE(PG8_SB(0, 0), b2, voffB); PG8_STAGE(PG8_SB(0, 1), b2 + hstep, voffB); PG8_STAGE(PG8_SA(0, 0), a2, vX0);
            PG8_WAIT_V(8); PG8_WAIT_L(0); PG8_BAR; PG8_MMA(1, 0, At, B0); PG8_MMA(1, 1, At, B1); PG8_BAR; PG8_SCHED;
            PG8_LDB(B0, 1, 0); PG8_LDB(B1, 1, 1); PG8_SCHED; PG8_LDA(At, 1, 0); PG8_STAGE(PG8_SA(0, 1), a2, vX1);
            PG8_WAIT_V(8); PG8_WAIT_L(0); PG8_BAR; PG8_MMA(0, 0, At, B0); PG8_MMA(0, 1, At, B1); PG8_BAR; PG8_SCHED;
            PG8_LDA(At, 1, 1); PG8_STAGE(PG8_SB(1, 0), b3, voffB); PG8_STAGE(PG8_SB(1, 1), b3 + hstep, voffB); PG8_STAGE(PG8_SA(1, 0), a3, vX0);
            PG8_WAIT_V(8); PG8_WAIT_L(0); PG8_BAR; PG8_MMA(1, 0, At, B0); PG8_MMA(1, 1, At, B1); PG8_BAR; PG8_SCHED;
        }
        if constexpr (ALIGN_EPI) { if (wr == 0) PG8_BAR; }
        if constexpr (FP8) { asm volatile("s_nop 15\n\ts_nop 15" ::: "memory"); }
        E(acc, cur, wr, wc, fr, fq);
        if (!has_next) break;
#pragma unroll
        for (int a = 0; a < 2; ++a)
#pragma unroll
            for (int b = 0; b < 2; ++b)
#pragma unroll
                for (int m = 0; m < 4; ++m)
#pragma unroll
                    for (int n = 0; n < 2; ++n) acc[a][b][m][n] = (f32x4){0.f, 0.f, 0.f, 0.f};
        cur = nxt; cA = nA; cB = nB; ++ui;
#pragma unroll
        for (int h = 0; h < 2; ++h)
#pragma unroll
            for (int i = 0; i < 2; ++i) vAc[h][i] = vAn[h][i];
        if constexpr (Sched::GATHER) {
            if (g_nn) PG8_AFIN(vAn, rawN);
            nxt = nn; g_next = g_nn;
        }
        if constexpr (ALIGN_EPI) { if (wr == 1) PG8_BAR; }
    }
    PG8_WAIT_V(0);
    if constexpr (!ALIGN_EPI) { if (wr == 0) PG8_BAR; }
    PG8_BAR;
#undef PG8_SA
#undef PG8_SB
#undef PG8_STAGE
#undef PG8_LDA
#undef PG8_LDB
#undef PG8_MMA
#undef PG8_LD8
#undef PG8_WAIT_V
#undef PG8_WAIT_L
#undef PG8_BAR
#undef PG8_SCHED
#undef PG8_AOFF
#undef PG8_ARAW
#undef PG8_AFIN
}
}

namespace att {
constexpr int KOFF = 0, VOFF = 32768, WSF_OFF = 65536, C_OFF = 69632, ATT_LDS = C_OFF + 16384;
constexpr float THR = 8.0f;
typedef short v4i16_t __attribute__((ext_vector_type(4)));
__device__ __forceinline__ int crow(int r, int hi) { return (r & 3) + 8 * (r >> 2) + 4 * hi; }
__device__ __forceinline__ float max3f(float a, float b, float c) { return __builtin_fmaxf(__builtin_fmaxf(a, b), c); }
__device__ __forceinline__ unsigned cvtpk(float lo, float hi) { typedef __bf16 bf16x2_t __attribute__((ext_vector_type(2))); f32x2 v = {lo, hi}; bf16x2_t b = __builtin_convertvector(v, bf16x2_t); return __builtin_bit_cast(unsigned, b); }
__device__ __forceinline__ s16x4 vtr(const LAS unsigned char* p) { return __builtin_bit_cast(s16x4, __builtin_amdgcn_ds_read_tr16_b64_v4i16((LAS v4i16_t*)p)); }

struct Prm {
    const bf16_t* Q; int qp;
    const bf16_t* K; int kp;
    const bf16_t* V; int vp;
    bf16_t* O; int op;
    int q0;
    int kt0, kt1;
    int nkeys;
    int window;
    const LAS float* c; int cpos0;
    float sink2;
    float kmaxA, kmaxB;
};

struct NoBg { __device__ __forceinline__ bool inflight() const { return false; } __device__ __forceinline__ void tick() {} __device__ __forceinline__ void issue() {} };
template <int D, bool MASK, bool BIAS, bool SINK, bool REV, bool O8, class BG>
__device__ __forceinline__ void attn_unit(const Prm& P, LAS unsigned char* lds, BG& bg) {
    constexpr int NCHK = D / 8, KSLOT = 64 * D * 2, NDB = D / 32, NKS = D / 16;
    const int tid = threadIdx.x, lane = tid & 63, r32 = lane & 31, hi = lane >> 5; const int wid = __builtin_amdgcn_readfirstlane(tid >> 6);
    LAS float* wsf = (LAS float*)(lds + WSF_OFF) + wid * 64;
    const int qw = P.q0 + wid * 32, qpos = qw + r32;
    auto dma_tile = [&](int t, int s) {
        const int kbase = t * 64;
#pragma unroll
        for (int cc = 0; cc < NCHK / 8; ++cc) {
            const int ch = wid + 8 * cc;
            int row = kbase + lane; row = row < 0 ? 0 : (row >= P.nkeys ? P.nkeys - 1 : row);
            __builtin_amdgcn_global_load_lds((const unsigned*)(P.K + (size_t)row * P.kp + ch * 8), (LAS unsigned*)(lds + KOFF + s * KSLOT + ch * 1024), 16, 0, 0);
            const int dblk = ch >> 2, rg = ch & 3;
            int vrow = kbase + 16 * rg + (lane >> 2); vrow = vrow < 0 ? 0 : (vrow >= P.nkeys ? P.nkeys - 1 : vrow);
            __builtin_amdgcn_global_load_lds((const unsigned*)(P.V + (size_t)vrow * P.vp + dblk * 32 + (lane & 3) * 8), (LAS unsigned*)(lds + VOFF + s * KSLOT + ch * 1024), 16, 0, 0);
        }
    };
    dma_tile(REV ? P.kt1 - 1 : P.kt0, 0);
    bf16x8 qr[NKS];
#pragma unroll
    for (int d0 = 0; d0 < NKS; ++d0) qr[d0] = *(const bf16x8*)(P.Q + (size_t)(wid * 32 + r32) * P.qp + d0 * 16 + hi * 8);
    const float cq = BIAS ? P.c[qpos - P.cpos0] : 0.f;
    float mhat = SINK ? P.sink2 : 0.f, l_reg = (SINK && hi == 0) ? 1.f : 0.f;
    bool first = !SINK;
    f32x16 o[NDB];
#pragma unroll
    for (int d = 0; d < NDB; ++d) o[d] = f32x16{};
    float qbnd = 0.f;
    if (REV) {
        float a = 0.f, b = 0.f;
#pragma unroll
        for (int d0 = 0; d0 < NKS; ++d0)
#pragma unroll
            for (int j = 0; j < 8; ++j) { const float v = __builtin_bit_cast(float, (unsigned)(unsigned short)qr[d0][j] << 16); if (d0 < NKS / 2) a += v * v; else b += v * v; }
        { auto rr = __builtin_amdgcn_permlane32_swap(__float_as_uint(a), __float_as_uint(a), false, false); a = __uint_as_float(rr[0]) + __uint_as_float(rr[1]); }
        { auto rr = __builtin_amdgcn_permlane32_swap(__float_as_uint(b), __float_as_uint(b), false, false); b = __uint_as_float(rr[0]) + __uint_as_float(rr[1]); }
        qbnd = 1.02f * (sqrtf(a) * P.kmaxA + sqrtf(b) * P.kmaxB) + 30.0f + cq;
    }
    LAS int* nflag = (LAS int*)(lds + WSF_OFF + 2048);
    int need_cur = 1, need_nxt = 1;
    const int NT = P.kt1 - P.kt0;
    for (int k = 0; k < NT; ++k) {
        const int t = REV ? P.kt1 - 1 - k : P.kt0 + k;
        const int s = k & 1, kbase = t * 64;
        if (k != 0 && bg.inflight()) asm volatile("s_waitcnt vmcnt(16)" ::: "memory");
        else asm volatile("s_waitcnt vmcnt(0)" ::: "memory");
        __syncthreads();
        bool more = k + 1 < NT;
        if (REV && more && k >= 1) { int any = 0;
#pragma unroll
            for (int w = 0; w < 8; ++w) any |= nflag[((k - 1) & 1) * 8 + w];
            more = any != 0; }
        bg.tick();
        if (more) dma_tile(REV ? t - 1 : t + 1, s ^ 1);
        bg.issue();
        bool compute = true, need_mask = false;
        if (MASK) {
            compute = !(kbase > qw + 31 || kbase + 63 < qw - P.window + 1) && (!REV || need_cur != 0);
            need_mask = (kbase + 63 > qw) || (kbase < qw + 31 - P.window + 1) || (kbase < 0);
        }
        if (compute) {
            const float cinit = cq - mhat;
            f32x16 p0, p1;
#pragma unroll
            for (int r = 0; r < 16; ++r) { p0[r] = cinit; p1[r] = cinit; }
            const LAS unsigned char* ks = lds + KOFF + s * KSLOT + hi * 1024 + r32 * 16;
#pragma unroll
            for (int d0 = 0; d0 < NKS; ++d0) {
                const bf16x8 b0 = *(const LAS bf16x8*)(ks + d0 * 2048), b1 = *(const LAS bf16x8*)(ks + d0 * 2048 + 512);
                p0 = __builtin_amdgcn_mfma_f32_32x32x16_bf16(b0, qr[d0], p0, 0, 0, 0);
                p1 = __builtin_amdgcn_mfma_f32_32x32x16_bf16(b1, qr[d0], p1, 0, 0, 0);
            }
            if (BIAS) {
                const LAS float* cb = P.c + (kbase - P.cpos0) + 4 * hi;
#pragma unroll
                for (int g = 0; g < 4; ++g) {
                    const f32x4 a = *(const LAS f32x4*)(cb + 8 * g), b = *(const LAS f32x4*)(cb + 32 + 8 * g);
#pragma unroll
                    for (int j = 0; j < 4; ++j) { p0[4 * g + j] -= a[j]; p1[4 * g + j] -= b[j]; }
                }
            }
            if (MASK && need_mask) {
                const int dq = qpos - kbase; int lo = dq - P.window + 1; lo = lo > -kbase ? lo : -kbase;
                const int lo2 = lo - 4 * hi, hi2 = dq - 4 * hi;
#pragma unroll
                for (int r = 0; r < 16; ++r) {
                    const int kr = (r & 3) + 8 * (r >> 2);
                    if (!(kr >= lo2 && kr <= hi2)) p0[r] = -INFINITY;
                    if (!(kr + 32 >= lo2 && kr + 32 <= hi2)) p1[r] = -INFINITY;
                }
            }
            float a = max3f(p0[0], p0[1], p1[0]), b = max3f(p0[2], p0[3], p1[1]); a = max3f(a, p1[2], p1[3]);
#pragma unroll
            for (int r = 4; r < 16; r += 4) { a = max3f(a, p0[r], p0[r + 1]); b = max3f(b, p0[r + 2], p0[r + 3]); a = max3f(a, p1[r], p1[r + 1]); b = max3f(b, p1[r + 2], p1[r + 3]); }
            float rm = __builtin_fmaxf(a, b);
            { auto rr = __builtin_amdgcn_permlane32_swap(__float_as_uint(rm), __float_as_uint(rm), false, false); rm = __builtin_fmaxf(__uint_as_float(rr[0]), __uint_as_float(rr[1])); }
            if (first || __any(rm > THR)) {
                float dl = first ? rm : __builtin_fmaxf(rm, 0.f);
                if (!(dl > -1e30f)) dl = 0.f;
                mhat += dl;
#pragma unroll
                for (int r = 0; r < 16; ++r) { p0[r] -= dl; p1[r] -= dl; }
                if (!first) {
                    const float f = __builtin_amdgcn_exp2f(-dl); l_reg *= f;
                    if (hi == 0) wsf[r32] = f;
                    LDS_WAIT();
#pragma unroll
                    for (int g = 0; g < 4; ++g) { const f32x4 fv = *(const LAS f32x4*)(wsf + 8 * g + 4 * hi);
#pragma unroll
                        for (int d = 0; d < NDB; ++d)
#pragma unroll
                            for (int j = 0; j < 4; ++j) o[d][4 * g + j] *= fv[j]; }
                }
                first = false;
            }
            float sacc = 0.f;
#pragma unroll
            for (int r = 0; r < 16; ++r) { p0[r] = __builtin_amdgcn_exp2f(p0[r]); p1[r] = __builtin_amdgcn_exp2f(p1[r]); sacc += p0[r] + p1[r]; }
            l_reg += sacc;
            u32x4 pw[4];
#pragma unroll
            for (int q = 0; q < 4; ++q) { pw[0][q] = cvtpk(p0[2 * q], p0[2 * q + 1]); pw[1][q] = cvtpk(p0[8 + 2 * q], p0[9 + 2 * q]); pw[2][q] = cvtpk(p1[2 * q], p1[2 * q + 1]); pw[3][q] = cvtpk(p1[8 + 2 * q], p1[9 + 2 * q]); }
            const LAS unsigned char* vs = lds + VOFF + s * KSLOT + ((lane >> 4) & 1) * 32 + (lane & 3) * 8 + (4 * hi + ((lane & 15) >> 2)) * 64;
#pragma unroll
            for (int d = 0; d < NDB; ++d)
#pragma unroll
                for (int k4 = 0; k4 < 4; ++k4) {
                    const s16x4 vlo = vtr(vs + d * 4096 + k4 * 1024), vhi = vtr(vs + d * 4096 + k4 * 1024 + 512);
                    const bf16x8 vf = (bf16x8){vlo[0], vlo[1], vlo[2], vlo[3], vhi[0], vhi[1], vhi[2], vhi[3]};
                    o[d] = __builtin_amdgcn_mfma_f32_32x32x16_bf16(__builtin_bit_cast(bf16x8, pw[k4]), vf, o[d], 0, 0, 0);
                }
        }
        if (REV) {
            int nn = 0;
            if (t - 2 >= P.kt0) { const float ck = P.c[64 * (t - 1) - 1 - P.cpos0]; nn = (first || __any(qbnd - ck - mhat >= 0.f)) ? 1 : 0; }
            if (lane == 0) nflag[(k & 1) * 8 + wid] = nn;
            need_cur = need_nxt; need_nxt = nn;
            if (!more) break;
        }
    }
    { auto rr = __builtin_amdgcn_permlane32_swap(__float_as_uint(l_reg), __float_as_uint(l_reg), false, false); l_reg = __uint_as_float(rr[0]) + __uint_as_float(rr[1]); }
    if (hi == 0) wsf[32 + r32] = l_reg;
    LDS_WAIT();
    float rli[16];
#pragma unroll
    for (int g = 0; g < 4; ++g) { const f32x4 lv = *(const LAS f32x4*)(wsf + 32 + 8 * g + 4 * hi);
#pragma unroll
        for (int j = 0; j < 4; ++j) rli[4 * g + j] = __builtin_amdgcn_rcpf(lv[j]); }
    __syncthreads();
    int ln = lane; asm volatile("" : "+v"(ln));
    const int r32e = ln & 31, hie = ln >> 5;
    if constexpr (O8) {
        LAS unsigned char* stg = lds + wid * (32 * D) + (4 * hie) * D + r32e;
#pragma unroll
        for (int r = 0; r < 16; ++r) { const int orow = (r & 3) + 8 * (r >> 2);
#pragma unroll
            for (int d = 0; d < NDB; ++d) { const float v = o[d][r] * rli[r]; stg[orow * D + d * 32] = (unsigned char)(__builtin_amdgcn_cvt_pk_fp8_f32(v, v, 0, false) & 0xff); } }
        LDS_WAIT();
        constexpr int CPR = D / 16, RPI = 64 / CPR;
        const LAS unsigned char* stg2 = lds + wid * (32 * D) + (ln / CPR) * D + (ln % CPR) * 16;
        unsigned char* Ow = (unsigned char*)P.O + (size_t)(wid * 32 + ln / CPR) * P.op + (ln % CPR) * 16;
#pragma unroll
        for (int i = 0; i < 32 / RPI; ++i) { const u32x4 v = *(const LAS u32x4*)(stg2 + i * RPI * D); *(u32x4*)(Ow + (size_t)(i * RPI) * P.op) = v; }
    } else {
    LAS bf16_t* stg = (LAS bf16_t*)(lds + wid * (32 * D * 2)) + (4 * hie) * D + r32e;
#pragma unroll
    for (int r = 0; r < 16; ++r) { const int orow = (r & 3) + 8 * (r >> 2);
#pragma unroll
        for (int d = 0; d < NDB; ++d) stg[orow * D + d * 32] = (bf16_t)f2bf(o[d][r] * rli[r]); }
    LDS_WAIT();
    constexpr int CPR = D / 8, RPI = 64 / CPR;
    const LAS bf16_t* stg2 = (const LAS bf16_t*)(lds + wid * (32 * D * 2)) + (ln / CPR) * D + (ln % CPR) * 8;
    bf16_t* Ow = P.O + (size_t)(wid * 32 + ln / CPR) * P.op + (ln % CPR) * 8;
#pragma unroll
    for (int i = 0; i < 32 / RPI; ++i) { const u32x4 v = *(const LAS u32x4*)(stg2 + i * RPI * D); *(u32x4*)(Ow + (size_t)(i * RPI) * P.op) = v; }
    }
    LDS_WAIT();
    __syncthreads();
}
}

struct Frame {
    LAS unsigned char* lds; volatile LAS unsigned* MISC; unsigned* ctl;
    int tid, lane, wave, vcu, G;
    const float *x, *mem, *g_mix, *w_in, *b_forget, *sinks, *w_out, *g_cross, *g_mem, *w_cq, *w_ckv, *w_co, *g_moe, *w_router, *b_router, *w_mlp1, *b_mlp1, *w_mlp2, *b_mlp2, *g_final;
    float* out; unsigned char* ws;
};
#define WSP(T, off) ((T*)(F.ws + (off)))

template <int MAP> __device__ __forceinline__ int rowmap(int n) {
    if (MAP == 1) return n < 3072 ? n : (n < 3088 ? 4608 + (n - 3072) : n - 16);
    if (MAP == 2) { const int o = n >> 1, bj = n & 1; return 256 * (o >> 7) + 128 * bj + (o & 127); }
    return n;
}
__device__ __forceinline__ int tr_rowmap(int map, int n) { return map == 1 ? (n < 3072 ? n : (n < 3088 ? 4608 + (n - 3072) : n - 16)) : n; }
__device__ __forceinline__ void tr_load(float (&v)[32], const float* W, int ldw, int ncols, int k0, int n0, int lane) {
    int nn = n0 + (lane & 31); nn = nn < ncols ? nn : ncols - 1;
    const float* p = W + (size_t)(k0 + (lane >> 5)) * ldw + nn;
#pragma unroll
    for (int i = 0; i < 32; ++i) v[i] = p[(size_t)(2 * i) * ldw];
}
__device__ __forceinline__ void tr_store(bf16_t* WT, const float* g, int ncols, int K, int map, int k0, int n0, LAS float* scr, int lane) {
    const int c = lane & 7;
    f32x4 g0 = (f32x4){1.f, 1.f, 1.f, 1.f}, g1 = g0;
    if (g) { g0 = *(const f32x4*)(g + k0 + 8 * c); g1 = *(const f32x4*)(g + k0 + 8 * c + 4); }
#pragma unroll
    for (int j = 0; j < 4; ++j) { const int nl = (lane >> 3) + 8 * j, n = n0 + nl; const LAS float* s = scr + (8 * c) * 33 + nl;
        u32x4 o; o.x = pk2(s[0 * 33] * g0[0], s[1 * 33] * g0[1]); o.y = pk2(s[2 * 33] * g0[2], s[3 * 33] * g0[3]); o.z = pk2(s[4 * 33] * g1[0], s[5 * 33] * g1[1]); o.w = pk2(s[6 * 33] * g1[2], s[7 * 33] * g1[3]);
        if (n < ncols) *(u32x4*)(WT + (size_t)tr_rowmap(map, n) * K + k0 + 8 * c) = o; }
}
__device__ __forceinline__ void tr_store_f8(unsigned char* WT, int K, int k0, int n0, LAS float* scr, int lane) {
    const int c = lane & 3;
#pragma unroll
    for (int j = 0; j < 2; ++j) { const int nl = (lane >> 2) + 16 * j; const LAS float* s = scr + (16 * c) * 33 + nl; u32x4 o;
#pragma unroll
        for (int q = 0; q < 4; ++q) o[q] = pk4_fp8(s[(4 * q) * 33] * WSCALE, s[(4 * q + 1) * 33] * WSCALE, s[(4 * q + 2) * 33] * WSCALE, s[(4 * q + 3) * 33] * WSCALE);
        *(u32x4*)(WT + (size_t)(n0 + nl) * K + k0 + 16 * c) = o; }
}
__device__ __forceinline__ void row_to_bf16(const float* xrow, bf16_t* orow, float* rstd_out, int lane) {
    const f32x4* xr = (const f32x4*)xrow + lane;
    f32x4 v[8]; float s = 0.f;
#pragma unroll
    for (int j = 0; j < 8; ++j) { v[j] = xr[64 * j]; s += (v[j].x * v[j].x + v[j].y * v[j].y) + (v[j].z * v[j].z + v[j].w * v[j].w); }
    s = wave_sum(s);
    if (lane == 0) *rstd_out = 1.0f / sqrtf(s * (1.0f / DM) + RMS_EPS);
    u32x2* o8 = (u32x2*)orow + lane;
#pragma unroll
    for (int j = 0; j < 8; ++j) { u32x2 w; w.x = pk2(v[j].x, v[j].y); w.y = pk2(v[j].z, v[j].w); o8[64 * j] = w; }
}
constexpr int CVT_ITEMS1 = NE * 16 * 32, CVT_ITEMS2 = NE * 16 * 16, CVT_ITEMS = CVT_ITEMS1 + CVT_ITEMS2;
constexpr int BG_PACE = 2;
constexpr int CVT_P9_ITEMS = 2048;
constexpr int CVT_P9_E0 = 24;
constexpr int CVT_P4_ITEMS = 6144;
constexpr int CVT_P1_ITEMS = 2048;
constexpr int CVT_P0_ITEMS = 0;
struct CvtBuf { f32x4 v[16]; };
struct CvtDesc { const float* W; unsigned char* WT; int ldw, n0, kb0, k0, map; };
__device__ __forceinline__ CvtDesc cvt_desc(const Frame& F, int item, int sub2, int h) {
    CvtDesc d; int kblk, nblk;
    if (item < CVT_ITEMS1) { const int e = item >> 9, rem = item & 511; kblk = rem >> 5; nblk = rem & 31; d.W = F.w_mlp1 + (size_t)e * DM * 2 * DE; d.ldw = 2 * DE; d.WT = F.ws + WS_W1 + (size_t)e * 2 * DE * DM; d.map = 2; }
    else { const int it = item - CVT_ITEMS1; const int e = it >> 8, rem = it & 255; kblk = rem >> 4; nblk = rem & 15; d.W = F.w_mlp2 + (size_t)e * DE * DM; d.ldw = DM; d.WT = F.ws + WS_W2 + (size_t)e * DM * DE; d.map = 0; }
    d.n0 = nblk * 128; d.kb0 = kblk * 128; d.k0 = d.kb0 + 64 * h + 32 * sub2;
    return d;
}
__device__ __forceinline__ void cvt_load(CvtBuf& b, const CvtDesc& d, int lane) {
    const float* p = d.W + (size_t)(d.k0 + 16 * (lane >> 5)) * d.ldw + d.n0 + 4 * (lane & 31);
#pragma unroll
    for (int i = 0; i < 16; ++i) b.v[i] = __builtin_nontemporal_load((const f32x4*)(p + (size_t)i * d.ldw));
}
__device__ __forceinline__ void cvt_to_lds(const CvtBuf& b, const CvtDesc& d, LAS unsigned char* img, const LAS float* gl, int sub2, int h, int lane) {
    const int hh = lane >> 5, l5 = lane & 31;
    float gs[16];
    const bool use_g = d.map == 2;
#pragma unroll
    for (int q = 0; q < 4; ++q) { const f32x4 gv = *(const LAS f32x4*)(gl + d.k0 + 16 * hh + 4 * q);
#pragma unroll
        for (int j = 0; j < 4; ++j) gs[4 * q + j] = use_g ? gv[j] : WSCALE; }
    const int c8 = 4 * h + 2 * sub2 + hh;
#pragma unroll
    for (int j = 0; j < 4; ++j) { u32x4 o;
#pragma unroll
        for (int q = 0; q < 4; ++q) { const int i = 4 * q; o[q] = pk4_fp8(b.v[i][j] * gs[i], b.v[i + 1][j] * gs[i + 1], b.v[i + 2][j] * gs[i + 2], b.v[i + 3][j] * gs[i + 3]); }
        *(LAS u32x4*)(img + (4 * l5 + j) * 128 + 16 * (c8 ^ (l5 & 7))) = o; }
}
__device__ __forceinline__ void cvt_flush(const CvtDesc& d, LAS unsigned char* img, int h, int lane) {
#pragma unroll 4
    for (int it = 0; it < 8; ++it) { const int r = 64 * h + (lane >> 3) + 8 * it, c = lane & 7;
        const u32x4 o = *(const LAS u32x4*)(img + r * 128 + 16 * (c ^ ((r >> 2) & 7)));
        const int n = d.n0 + r; int row = n; if (d.map == 2) { const int oo = n >> 1, bj = n & 1; row = 256 * (oo >> 7) + 128 * bj + (oo & 127); }
        __builtin_nontemporal_store(o, (u32x4*)(d.WT + (size_t)row * DM + d.kb0 + 16 * c)); }
}
__device__ __forceinline__ void cvt_fill_g(const Frame& F) { LAS float* gl = (LAS float*)(F.lds + BG_G_OFF); for (int i = F.tid; i < DM; i += NTHREADS) gl[i] = F.g_moe[i] * WSCALE; __syncthreads(); }
struct Bg {
    CvtBuf buf; const Frame* F; LAS unsigned char* img; const LAS float* gl; int q, nq, pgw, npg, state, ctr, h, fitem;
    __device__ __forceinline__ void init(const Frame& F_, int first_item, int n_items) { init(F_, first_item, n_items, F_.vcu, F_.G); }
    __device__ __forceinline__ void init(const Frame& F_, int first_item, int n_items, int rank, int nranks) {
        F = &F_; img = F_.lds + BG_OFF + (F_.wave >> 1) * 16384; gl = (const LAS float*)(F_.lds + BG_G_OFF); pgw = first_item + rank * 4 + (F_.wave >> 1); npg = nranks * 4; h = F_.wave & 1;
        const int last = first_item + n_items; const int nit = pgw < last ? (last - pgw + npg - 1) / npg : 0; q = 0; nq = nit * 2; state = 0; ctr = 0; fitem = -1; }
    __device__ __forceinline__ int item_of(int qq) const { return pgw + (qq >> 1) * npg; }
    __device__ __forceinline__ CvtDesc desc(int qq) const { return cvt_desc(*F, item_of(qq), qq & 1, h); }
    __device__ __forceinline__ bool inflight() const { return state == 1; }
    __device__ __forceinline__ void proc() { cvt_to_lds(buf, desc(q), img, gl, q & 1, h, F->lane); if (q & 1) fitem = item_of(q); ++q; }
    __device__ __forceinline__ void flush() { if (fitem >= 0) { cvt_flush(cvt_desc(*F, fitem, 0, h), img, h, F->lane); fitem = -1; } }
    __device__ __forceinline__ void tick() { flush(); if (state == 2) { proc(); state = 0; } else if (state == 1) state = 2; }
    __device__ __forceinline__ void issue() { if (state == 0 && q < nq && ctr <= 0) { cvt_load(buf, desc(q), F->lane); state = 1; ctr = BG_PACE; } --ctr; }
    __device__ __forceinline__ void drain() {
        __syncthreads(); flush(); __syncthreads();
        if (state != 0) { proc(); state = 0; if (fitem >= 0) { __syncthreads(); flush(); __syncthreads(); } }
        if (q >= nq) { __syncthreads(); return; }
        CvtBuf b2;
        cvt_load(buf, desc(q), F->lane);
        while (q < nq) {
            if (q + 1 < nq) cvt_load(b2, desc(q + 1), F->lane);
            cvt_to_lds(buf, desc(q), img, gl, q & 1, h, F->lane); if (q & 1) fitem = item_of(q); ++q;
            if (fitem >= 0) { __syncthreads(); flush(); __syncthreads(); }
            if (q >= nq) break;
            if (q + 1 < nq) cvt_load(buf, desc(q + 1), F->lane);
            cvt_to_lds(b2, desc(q), img, gl, q & 1, h, F->lane); if (q & 1) fitem = item_of(q); ++q;
            if (fitem >= 0) { __syncthreads(); flush(); __syncthreads(); }
        }
    }
};
__device__ __forceinline__ void row2_to_bf16(const float* xrow, bf16_t* orow, float* rstd_out, size_t rowdist, int rdist, int lane) {
    const f32x4* xa = (const f32x4*)xrow + lane; const f32x4* xb = (const f32x4*)(xrow + rowdist) + lane;
    f32x4 va[8], vb[8]; float sa = 0.f, sb = 0.f;
#pragma unroll
    for (int j = 0; j < 8; ++j) { va[j] = xa[64 * j]; vb[j] = xb[64 * j]; }
#pragma unroll
    for (int j = 0; j < 8; ++j) { sa += (va[j].x * va[j].x + va[j].y * va[j].y) + (va[j].z * va[j].z + va[j].w * va[j].w); sb += (vb[j].x * vb[j].x + vb[j].y * vb[j].y) + (vb[j].z * vb[j].z + vb[j].w * vb[j].w); }
    sa = wave_sum(sa); sb = wave_sum(sb);
    if (lane == 0) { rstd_out[0] = 1.0f / sqrtf(sa * (1.0f / DM) + RMS_EPS); rstd_out[rdist] = 1.0f / sqrtf(sb * (1.0f / DM) + RMS_EPS); }
    u32x2* oa = (u32x2*)orow + lane; u32x2* ob = (u32x2*)(orow + rowdist) + lane;
#pragma unroll
    for (int j = 0; j < 8; ++j) { u32x2 w; w.x = pk2(va[j].x, va[j].y); w.y = pk2(va[j].z, va[j].w); oa[64 * j] = w; u32x2 w2; w2.x = pk2(vb[j].x, vb[j].y); w2.y = pk2(vb[j].z, vb[j].w); ob[64 * j] = w2; }
}
__device__ __forceinline__ void p0_prologue(Frame& F) {
    LAS float* scr = (LAS float*)(F.lds + F.wave * 16384);
    const int gw = F.vcu * NWAVES + F.wave, NGW = F.G * NWAVES;
    constexpr int I_IN = 32 * 145, I_OUT = 32 * 64, I_CQ = 32 * 16, I_CKV = 32 * 32, I_CO = 8 * 64;
    constexpr int NSMALL = I_IN + I_OUT + I_CQ + I_CKV + I_CO;
    constexpr int NITEMS = NSMALL;
    bf16_t* WIN = WSP(bf16_t, WS_WIN);
#define TR_LOAD(it_) do { int r_ = (it_); \
        if (r_ < I_IN) tr_load(va, F.w_in, IN_COLS, IN_COLS, 64 * (r_ / 145), 32 * (r_ % 145), F.lane); \
        else if ((r_ -= I_IN) < I_OUT) tr_load(va, F.w_out, DM, DM, 64 * (r_ / 64), 32 * (r_ % 64), F.lane); \
        else if ((r_ -= I_OUT) < I_CQ) tr_load(va, F.w_cq, CW, CW, 64 * (r_ / 16), 32 * (r_ % 16), F.lane); \
        else if ((r_ -= I_CQ) < I_CKV) tr_load(va, F.w_ckv, 2 * CW, 2 * CW, 64 * (r_ / 32), 32 * (r_ % 32), F.lane); \
        else { r_ -= I_CKV; tr_load(va, F.w_co, DM, DM, 64 * (r_ / 64), 32 * (r_ % 64), F.lane); } } while (0)
#define TR_STORE(it_) do { int r_ = (it_); \
        if (r_ < I_IN) tr_store(WIN, F.g_mix, IN_COLS, DM, 1, 64 * (r_ / 145), 32 * (r_ % 145), scr, F.lane); \
        else if ((r_ -= I_IN) < I_OUT) tr_store_f8(WSP(unsigned char, WS_WOUT), DM, 64 * (r_ / 64), 32 * (r_ % 64), scr, F.lane); \
        else if ((r_ -= I_OUT) < I_CQ) tr_store(WSP(bf16_t, WS_WCQ), F.g_cross, CW, DM, 0, 64 * (r_ / 16), 32 * (r_ % 16), scr, F.lane); \
        else if ((r_ -= I_CQ) < I_CKV) tr_store(WSP(bf16_t, WS_WCKV), F.g_mem, 2 * CW, DM, 0, 64 * (r_ / 32), 32 * (r_ % 32), scr, F.lane); \
        else { r_ -= I_CKV; tr_store(WSP(bf16_t, WS_WCO), nullptr, DM, CW, 0, 64 * (r_ / 64), 32 * (r_ % 64), scr, F.lane); } } while (0)
    { float va[32]; int it = gw;
      if (it < NITEMS) TR_LOAD(it);
      while (it < NITEMS) {
#pragma unroll
          for (int i = 0; i < 32; ++i) scr[(2 * i + (F.lane >> 5)) * 33 + (F.lane & 31)] = va[i];
          const int itn = it + NGW;
          if (itn < NITEMS) TR_LOAD(itn);
          LDS_WAIT(); asm volatile("" ::: "memory");
          TR_STORE(it);
          LDS_WAIT(); asm volatile("" ::: "memory");
          it = itn;
      } }
#undef TR_LOAD
#undef TR_STORE
    if (CVT_P0_ITEMS > 0) { __syncthreads(); cvt_fill_g(F); Bg bg; bg.init(F, 0, CVT_P0_ITEMS); bg.drain(); }
    { u32x4* z = (u32x4*)(WIN + (size_t)IN_COLS * DM); const int nz = (INP - IN_COLS) * DM * 2 / 16;
      for (int i = F.vcu * NTHREADS + F.tid; i < nz; i += F.G * NTHREADS) z[i] = (u32x4){0u, 0u, 0u, 0u}; }
    { u32x4* wrb = WSP(u32x4, WS_WRG);
      for (int i = F.vcu * NTHREADS + F.tid; i < 32 * 4 * 2 * 64; i += F.G * NTHREADS) {
          const int ln = i & 63, pc = (i >> 6) & 1, j = (i >> 7) & 3, c = i >> 9;
          const int k0 = 64 * c + 32 * (ln >> 5) + 8 * j, n = ln & 31;
          unsigned hw[8];
#pragma unroll
          for (int t = 0; t < 8; ++t) { const float w = F.w_router[(size_t)(k0 + t) * NE + n] * F.g_moe[k0 + t]; const unsigned hi = f2bf(w); const float rest = w - __builtin_bit_cast(float, hi << 16); hw[t] = pc ? f2bf(rest) : hi; }
          wrb[i] = (u32x4){hw[0] | (hw[1] << 16), hw[2] | (hw[3] << 16), hw[4] | (hw[5] << 16), hw[6] | (hw[7] << 16)}; } }
    for (int m = gw; m < NTOK; m += 2 * NGW) row2_to_bf16(F.x + (size_t)m * DM, WSP(bf16_t, WS_XB) + (size_t)m * DM, WSP(float, WS_RSTD0) + m, (size_t)NGW * DM, NGW, F.lane);
    for (int m = gw; m < NBATCH * NMEM; m += NGW) row_to_bf16(F.mem + (size_t)m * DM, WSP(bf16_t, WS_MEMB) + (size_t)m * DM, WSP(float, WS_RSTDM) + m, F.lane);
}

using pg8::Unit;
struct SchedP1 {
    static constexpr bool GATHER = false;
    int G, c; const char *XB, *MEMB, *WIN, *WCKV;
    __device__ __forceinline__ bool next(int i, Unit& u) const {
        int L = i * G + c;
        if (L < 64 * 19) { pg8::grid_order(L, 64, 19, u.pm, u.pn); u.e = 0; u.aux = 0; return true; }
        L -= 64 * 19; if (L < 16) { u.pm = L >> 2; u.pn = L & 3; u.e = 1; u.aux = 0; return true; }
        return false;
    }
    __device__ __forceinline__ const char* a_base(const Unit& u) const { return u.e ? MEMB : XB; }
    __device__ __forceinline__ unsigned a_off(const Unit& u, int r) const { return (unsigned)(u.pm * 256 + r) * (unsigned)(DM * 2); }
    __device__ __forceinline__ const char* b_base(const Unit& u) const { return (u.e ? WCKV : WIN) + (size_t)u.pn * 256 * DM * 2; }
};
struct SchedGrid {
    static constexpr bool GATHER = false;
    int G, c, nM, nN, K; const char *A, *B;
    __device__ __forceinline__ bool next(int i, Unit& u) const { u.e = 0; u.aux = 0; return pg8::grid_order(i * G + c, nM, nN, u.pm, u.pn); }
    __device__ __forceinline__ const char* a_base(const Unit&) const { return A; }
    __device__ __forceinline__ unsigned a_off(const Unit& u, int r) const { return (unsigned)(u.pm * 256 + r) * (unsigned)(K * 2); }
    __device__ __forceinline__ const char* b_base(const Unit& u) const { return B + (size_t)u.pn * 256 * K * 2; }
};
template <bool MLP1> struct SchedMoe {
    static constexpr bool GATHER = MLP1;
    const LAS int* tab; int G, vcu; const char *A, *W; const int* rowlist; size_t estride; int i0, Lend;
    __device__ __forceinline__ bool next(int i, Unit& u) const {
        const int L = (i0 + i) * G + vcu; if (L >= Lend) return false;
        int e = 0;
#pragma unroll
        for (int st = 16; st >= 1; st >>= 1) if (tab[e + st] <= L) e += st;
        const int rem = L - tab[e], nt = tab[66 + e];
        const int pn = rem / nt, pm = rem - pn * nt;
        u.e = __builtin_amdgcn_readfirstlane(e); u.pn = __builtin_amdgcn_readfirstlane(pn); u.pm = __builtin_amdgcn_readfirstlane(pm);
        u.aux = __builtin_amdgcn_readfirstlane((tab[33 + e] + pm) * 256);
        return true;
    }
    __device__ __forceinline__ int nrows(const Unit& u) const { const int n = tab[98 + u.e] - u.pm * 256; return n < 256 ? n : 256; }
    __device__ __forceinline__ const char* a_base(const Unit&) const { return A; }
    __device__ __forceinline__ unsigned a_off(const Unit& u, int r) const {
        if (MLP1) { int pos = u.pm * 256 + r; const int last = tab[98 + u.e] - 1; pos = pos < last ? pos : last; const int ts = rowlist[u.e * ECAP + pos]; return (unsigned)(ts >> 2) * (unsigned)DM; }
        return (unsigned)(u.aux + r) * (unsigned)DE;
    }
    __device__ __forceinline__ int a_raw(const Unit& u, int r) const { int pos = u.pm * 256 + r; const int last = tab[98 + u.e] - 1; pos = pos < last ? pos : last; return rowlist[u.e * ECAP + pos]; }
    __device__ __forceinline__ unsigned a_fin(int ts) const { return (unsigned)(ts >> 2) * (unsigned)DM; }
    __device__ __forceinline__ const char* b_base(const Unit& u) const { return W + (size_t)u.e * estride + (size_t)u.pn * 256 * DM; }
};

typedef const f32x4 (&AccRef)[2][2][4][2];
struct EpiP1 {
    static constexpr bool PERM = true;
    bf16_t *FQ, *FK, *FV, *SQ, *SK, *SV, *CKV; const float *rstd0, *rstdm, *bforget; float* logf; unsigned* kmax;
    __device__ __forceinline__ void operator()(AccRef acc, const Unit& u, int wr, int wc, int fr, int fq) const {
        if (u.e == 0 && u.pn == 18) {
            if (wc == 0 && fq < 2) {
#pragma unroll
                for (int ai = 0; ai < 2; ++ai)
#pragma unroll
                    for (int m = 0; m < 4; ++m) { const int row = u.pm * 256 + ai * 128 + wr * 64 + m * 16 + fr; const float rs = rstd0[row]; const int b = row >> 12, s = row & 4095;
#pragma unroll
                        for (int n = 0; n < 2; ++n)
#pragma unroll
                            for (int j = 0; j < 4; ++j) { const int head = 8 * fq + 4 * n + j; const float z = rs * acc[ai][0][m][n][j] + bforget[head];
                                const float lf2 = __builtin_fminf(z, 0.f) * LOG2E - __builtin_amdgcn_logf(1.0f + __builtin_amdgcn_exp2f(-fabsf(z) * LOG2E)); logf[(size_t)(b * 16 + head) * SEQ + s] = lf2; } }
            }
            return;
        }
        bf16_t* dst; int ldc, col0; float sc = 1.f; const float* rs = rstd0;
        if (u.e == 1) { dst = CKV; ldc = 2 * CW; col0 = u.pn * 256; rs = rstdm; }
        else if (u.pn < 4) { dst = FQ; ldc = 1024; col0 = u.pn * 256; sc = C2_64; }
        else if (u.pn < 8) { dst = FK; ldc = 1024; col0 = (u.pn - 4) * 256; }
        else if (u.pn < 12) { dst = FV; ldc = 1024; col0 = (u.pn - 8) * 256; }
        else if (u.pn < 16) { dst = SQ; ldc = 1024; col0 = (u.pn - 12) * 256; sc = C2_64; }
        else if (u.pn == 16) { dst = SK; ldc = 256; col0 = 0; }
        else { dst = SV; ldc = 256; col0 = 0; }
        col0 += wc * 32 + 8 * fq;
        const bool is_fk = (u.e == 0 && u.pn >= 4 && u.pn < 8);
        float mx[2] = {0.f, 0.f};
        float rsv[8];
#pragma unroll
        for (int i = 0; i < 8; ++i) rsv[i] = rs[u.pm * 256 + (i >> 2) * 128 + wr * 64 + (i & 3) * 16 + fr];
#pragma unroll
        for (int ai = 0; ai < 2; ++ai)
#pragma unroll
            for (int m = 0; m < 4; ++m) { const int row = u.pm * 256 + ai * 128 + wr * 64 + m * 16 + fr; const float f = rsv[ai * 4 + m] * sc; bf16_t* rowp = dst + (size_t)row * ldc + col0;
#pragma unroll
                for (int bj = 0; bj < 2; ++bj) { const f32x4 v0 = acc[ai][bj][m][0] * f, v1 = acc[ai][bj][m][1] * f;
                    u32x4 w; w.x = cvt_pk_bf16(v0[0], v0[1]); w.y = cvt_pk_bf16(v0[2], v0[3]); w.z = cvt_pk_bf16(v1[0], v1[1]); w.w = cvt_pk_bf16(v1[2], v1[3]);
                    *(u32x4*)(rowp + bj * 128) = w;
                    if (is_fk) { float q = (v0[0] * v0[0] + v0[1] * v0[1]) + (v0[2] * v0[2] + v0[3] * v0[3]) + (v1[0] * v1[0] + v1[1] * v1[1]) + (v1[2] * v1[2] + v1[3] * v1[3]);
                        q += __shfl_xor(q, 16); q += __shfl_xor(q, 32); mx[bj] = __builtin_fmaxf(mx[bj], q); } } }
        if (is_fk) {
#pragma unroll
            for (int bj = 0; bj < 2; ++bj) { float q = mx[bj];
#pragma unroll
                for (int o = 1; o < 16; o <<= 1) q = __builtin_fmaxf(q, __shfl_xor(q, o));
                if (fr == 0 && fq == 0) { const int b = (u.pm * 256) >> 12, head = (u.pn - 4) * 4 + 2 * bj + (wc >> 1);
                    __hip_atomic_fetch_max(kmax + (b * 16 + head) * 2 + (wc & 1), __float_as_uint(q), __ATOMIC_RELAXED, __HIP_MEMORY_SCOPE_AGENT); } }
        }
    }
};
struct EpiRes {
    static constexpr bool PERM = true;
    const float* res; const bf16_t* resb; float* outf; bf16_t* outb; float* ssq; unsigned* out8; float ascale;
    __device__ __forceinline__ void operator()(AccRef acc, const Unit& u, int wr, int wc, int fr, int fq) const {
        const int col0 = u.pn * 256 + wc * 32 + 8 * fq;
#pragma unroll
        for (int ai = 0; ai < 2; ++ai) {
            f32x4 rv[4][2][2];
#pragma unroll
            for (int m = 0; m < 4; ++m) { const size_t off = (size_t)(u.pm * 256 + ai * 128 + wr * 64 + m * 16 + fr) * DM + col0;
#pragma unroll
                for (int bj = 0; bj < 2; ++bj) {
                    if (resb) { const u32x4 w = *(const u32x4*)(resb + off + bj * 128);
                        rv[m][bj][0] = (f32x4){bf_lo(w.x), bf_hi(w.x), bf_lo(w.y), bf_hi(w.y)}; rv[m][bj][1] = (f32x4){bf_lo(w.z), bf_hi(w.z), bf_lo(w.w), bf_hi(w.w)}; }
                    else { rv[m][bj][0] = *(const f32x4*)(res + off + bj * 128); rv[m][bj][1] = *(const f32x4*)(res + off + bj * 128 + 4); } } }
#pragma unroll
            for (int m = 0; m < 4; ++m) { const int row = u.pm * 256 + ai * 128 + wr * 64 + m * 16 + fr; const size_t off = (size_t)row * DM + col0; float ss = 0.f;
#pragma unroll
                for (int bj = 0; bj < 2; ++bj) { const size_t o2 = off + bj * 128; const f32x4 v0 = rv[m][bj][0] + acc[ai][bj][m][0] * ascale, v1 = rv[m][bj][1] + acc[ai][bj][m][1] * ascale;
                    if (outf) { *(f32x4*)(outf + o2) = v0; *(f32x4*)(outf + o2 + 4) = v1; }
                    if (outb) { u32x4 w; w.x = cvt_pk_bf16(v0[0], v0[1]); w.y = cvt_pk_bf16(v0[2], v0[3]); w.z = cvt_pk_bf16(v1[0], v1[1]); w.w = cvt_pk_bf16(v1[2], v1[3]); *(u32x4*)(outb + o2) = w; }
                    if (out8) { u32x2 w8; w8.x = pk4_fp8(v0[0], v0[1], v0[2], v0[3]); w8.y = pk4_fp8(v1[0], v1[1], v1[2], v1[3]); *(u32x2*)((unsigned char*)out8 + o2) = w8; }
                    ss += (v0[0] * v0[0] + v0[1] * v0[1]) + (v0[2] * v0[2] + v0[3] * v0[3]) + (v1[0] * v1[0] + v1[1] * v1[1]) + (v1[2] * v1[2] + v1[3] * v1[3]); }
                ss += __shfl_xor(ss, 16); ss += __shfl_xor(ss, 32);
                if (fq == 0) atomicAdd(ssq + row, ss); }
        }
    }
};
struct EpiCQ {
    static constexpr bool PERM = true;
    bf16_t* CQ; const float* ssq1;
    __device__ __forceinline__ void operator()(AccRef acc, const Unit& u, int wr, int wc, int fr, int fq) const {
        const int col0 = u.pn * 256 + wc * 32 + 8 * fq;
        float sq[8];
#pragma unroll
        for (int i = 0; i < 8; ++i) sq[i] = ssq1[u.pm * 256 + (i >> 2) * 128 + wr * 64 + (i & 3) * 16 + fr];
#pragma unroll
        for (int ai = 0; ai < 2; ++ai)
#pragma unroll
            for (int m = 0; m < 4; ++m) { const int row = u.pm * 256 + ai * 128 + wr * 64 + m * 16 + fr; const float f = C2_128 / sqrtf(sq[ai * 4 + m] * (1.0f / DM) + RMS_EPS); bf16_t* rowp = CQ + (size_t)row * CW + col0;
#pragma unroll
                for (int bj = 0; bj < 2; ++bj) { const f32x4 v0 = acc[ai][bj][m][0] * f, v1 = acc[ai][bj][m][1] * f;
                    u32x4 w; w.x = cvt_pk_bf16(v0[0], v0[1]); w.y = cvt_pk_bf16(v0[2], v0[3]); w.z = cvt_pk_bf16(v1[0], v1[1]); w.w = cvt_pk_bf16(v1[2], v1[3]);
                    *(u32x4*)(rowp + bj * 128) = w; } }
    }
};
__device__ __forceinline__ f32x4 swiglu4(f32x4 ug, f32x4 ul) {
    f32x4 xg, xl, e, sg;
#pragma unroll
    for (int j = 0; j < 4; ++j) { xg[j] = __builtin_fminf(ug[j], 7.0f); xl[j] = __builtin_fminf(__builtin_fmaxf(ul[j], -7.0f), 7.0f); }
    const f32x4 t = xg * (-1.702f * LOG2E);
#pragma unroll
    for (int j = 0; j < 4; ++j) e[j] = __builtin_amdgcn_exp2f(t[j]);
    const f32x4 d = e + 1.0f;
#pragma unroll
    for (int j = 0; j < 4; ++j) sg[j] = __builtin_amdgcn_rcpf(d[j]);
    return (xg * sg) * (xl + 1.0f);
}
__device__ __forceinline__ float swiglu1(float ug, float ul) {
    const float xg = __builtin_fminf(ug, 7.0f), xl = __builtin_fminf(__builtin_fmaxf(ul, -7.0f), 7.0f);
    const float sg = __builtin_amdgcn_rcpf(1.0f + __builtin_amdgcn_exp2f(-1.702f * LOG2E * xg));
    return xg * sg * (xl + 1.0f);
}
struct EpiMlp1 {
    static constexpr bool PERM = true;
    const LAS int* tab; const int* rowlist; const float* rowrs; const float* b1; unsigned char* H;
    __device__ __forceinline__ void operator()(AccRef acc, const Unit& u, int wr, int wc, int fr, int fq) const {
        const int o0 = u.pn * 128 + wc * 32 + 8 * fq; const int cnt = tab[98 + u.e];
        f32x4 bb[4];
#pragma unroll
        for (int q = 0; q < 4; ++q) bb[q] = *(const f32x4*)(b1 + (size_t)u.e * 2 * DE + 2 * o0 + 4 * q);
        f32x4 bgv[2], blv[2];
#pragma unroll
        for (int n = 0; n < 2; ++n)
#pragma unroll
            for (int j = 0; j < 4; ++j) { const int q = 4 * n + j; bgv[n][j] = bb[q >> 1][(q & 1) * 2]; blv[n][j] = bb[q >> 1][(q & 1) * 2 + 1]; }
        float rsv[8];
#pragma unroll
        for (int i = 0; i < 8; ++i) { int pos = u.pm * 256 + (i >> 2) * 128 + wr * 64 + (i & 3) * 16 + fr; pos = pos < cnt - 1 ? pos : cnt - 1; rsv[i] = rowrs[u.e * ECAP + pos] * WSCALE_INV; }
#pragma unroll
        for (int ai = 0; ai < 2; ++ai)
#pragma unroll
            for (int m = 0; m < 4; ++m) { const int r = ai * 128 + wr * 64 + m * 16 + fr, pos = u.pm * 256 + r; const bool valid = pos < cnt;
                const float rs = rsv[ai * 4 + m];
                const f32x4 h0 = swiglu4(acc[ai][0][m][0] * rs + bgv[0], acc[ai][1][m][0] * rs + blv[0]), h1 = swiglu4(acc[ai][0][m][1] * rs + bgv[1], acc[ai][1][m][1] * rs + blv[1]);
                u32x2 w; w.x = pk4_fp8(h0[0], h0[1], h0[2], h0[3]); w.y = pk4_fp8(h1[0], h1[1], h1[2], h1[3]);
                if (valid) *(u32x2*)(H + (size_t)(u.aux + r) * DE + o0) = w; }
    }
};
struct EpiMlp2 {
    static constexpr bool PERM = true;
    const LAS int* tab; const int* rowlist; const float* rowgate; const float* b2; unsigned char* Y;
    __device__ __forceinline__ void operator()(AccRef acc, const Unit& u, int wr, int wc, int fr, int fq) const {
        const int col0 = u.pn * 256 + wc * 32 + 8 * fq; const int cnt = tab[98 + u.e];
        f32x4 bv[2][2];
#pragma unroll
        for (int bj = 0; bj < 2; ++bj)
#pragma unroll
            for (int n = 0; n < 2; ++n) bv[bj][n] = *(const f32x4*)(b2 + (size_t)u.e * DM + col0 + bj * 128 + 4 * n);
        int tsv[8]; float gtv[8];
#pragma unroll
        for (int i = 0; i < 8; ++i) { int pos = u.pm * 256 + (i >> 2) * 128 + wr * 64 + (i & 3) * 16 + fr; pos = pos < cnt - 1 ? pos : cnt - 1; tsv[i] = rowlist[u.e * ECAP + pos]; gtv[i] = rowgate[u.e * ECAP + pos]; }
#pragma unroll
        for (int ai = 0; ai < 2; ++ai)
#pragma unroll
            for (int m = 0; m < 4; ++m) { const int r = ai * 128 + wr * 64 + m * 16 + fr, pos = u.pm * 256 + r; const bool valid = pos < cnt;
                const int ts = tsv[ai * 4 + m]; const float gt = gtv[ai * 4 + m];
                unsigned char* rowp = Y + (size_t)ts * DM + col0;
#pragma unroll
                for (int bj = 0; bj < 2; ++bj) { const f32x4 v0 = (acc[ai][bj][m][0] * WSCALE_INV + bv[bj][0]) * gt, v1 = (acc[ai][bj][m][1] * WSCALE_INV + bv[bj][1]) * gt;
                    u32x2 w; w.x = pk4_fp8(v0[0], v0[1], v0[2], v0[3]); w.y = pk4_fp8(v1[0], v1[1], v1[2], v1[3]);
                    if (valid) *(u32x2*)(rowp + bj * 128) = w; } }
    }
};

__device__ __forceinline__ void moe_tables(Frame& F, int ncol) {
    LAS int* tab = (LAS int*)(F.lds + TAB_OFF);
    if (F.wave == 0) {
        const int e = F.lane & 31;
        const int c = (int)__hip_atomic_load(F.ctl + CW_CNT + e, RLX_AGENT); const int nt = (c + 255) >> 8;
        int inc = nt;
#pragma unroll
        for (int o = 1; o < 32; o <<= 1) { const int t = __shfl_up(inc, o, 32); if (e >= o) inc += t; }
        const int excl = inc - nt;
        if (F.lane < 32) { tab[e] = excl * ncol; tab[33 + e] = excl; tab[66 + e] = nt > 0 ? nt : 1; tab[98 + e] = c;
            if (e == 31) { tab[32] = inc * ncol; tab[65] = inc; } }
    }
    __syncthreads();
}

constexpr int N_PHASES = 11;
struct Args { const float* in[20]; float* out; unsigned char* ws; int ph_lo, ph_hi; };
__global__ void __launch_bounds__(NTHREADS, 2) mk_fwd(Args args) {
    extern __shared__ __attribute__((aligned(16))) unsigned char lds_raw[];
    Frame F;
    F.lds = (LAS unsigned char*)lds_raw; F.MISC = (volatile LAS unsigned*)(F.lds + MISC_OFF);
    F.tid = threadIdx.x; F.lane = F.tid & 63; F.wave = __builtin_amdgcn_readfirstlane(F.tid >> 6);
    F.G = gridDim.x; { const int bx = blockIdx.x; F.vcu = (F.G % 8 == 0) ? (bx % 8) * (F.G / 8) + bx / 8 : bx; }
    F.ws = args.ws; F.ctl = (unsigned*)(args.ws + WS_CTL); F.out = args.out;
    F.x = args.in[0]; F.mem = args.in[1]; F.g_mix = args.in[2]; F.w_in = args.in[3]; F.b_forget = args.in[4]; F.sinks = args.in[5]; F.w_out = args.in[6]; F.g_cross = args.in[7]; F.g_mem = args.in[8];
    F.w_cq = args.in[9]; F.w_ckv = args.in[10]; F.w_co = args.in[11]; F.g_moe = args.in[12]; F.w_router = args.in[13]; F.b_router = args.in[14]; F.w_mlp1 = args.in[15]; F.b_mlp1 = args.in[16];
    F.w_mlp2 = args.in[17]; F.b_mlp2 = args.in[18]; F.g_final = args.in[19];
    for (int u = F.tid; u < (LDS_BYTES - TAB_OFF) / 4; u += NTHREADS) ((LAS unsigned*)(F.lds + TAB_OFF))[u] = 0u;
    __syncthreads();
    const int lo = args.ph_lo, hi = args.ph_hi;
    XcdBarrier bar; bar.bar = (unsigned*)(F.ctl + CW_BAR); bar.x = 0; bar.st = nullptr;
    if (hi - lo > 1) bar = xcd_barrier_post((unsigned*)(F.ctl + CW_BAR), F.MISC + 8);
#define IN(k) (lo <= (k) && (k) < hi)
#define SEAM(k) do { if (IN(k) && IN((k) + 1)) xcd_barrier(bar); } while (0)
    LAS unsigned char* lds = F.lds;

    if (IN(0)) { p0_prologue(F); }
    SEAM(0);
    if (IN(1)) {
        SchedP1 S{F.G, (int)blockIdx.x, (const char*)WSP(bf16_t, WS_XB), (const char*)WSP(bf16_t, WS_MEMB), (const char*)WSP(bf16_t, WS_WIN), (const char*)WSP(bf16_t, WS_WCKV)};
        EpiP1 E{WSP(bf16_t, WS_FQ), WSP(bf16_t, WS_FK), WSP(bf16_t, WS_FV), WSP(bf16_t, WS_SQ), WSP(bf16_t, WS_SK), WSP(bf16_t, WS_SV), WSP(bf16_t, WS_CKV), WSP(float, WS_RSTD0), WSP(float, WS_RSTDM), F.b_forget, WSP(float, WS_LOGF), F.ctl + CW_KMAX};
        pg8::gemm_phase<EpiP1, SchedP1, true, true>(lds, DM, S, E);
        if (F.G == 256 && blockIdx.x >= 208) {
            cvt_fill_g(F);
            Bg bg; bg.init(F, CVT_ITEMS - CVT_P9_ITEMS - CVT_P4_ITEMS - CVT_P1_ITEMS, CVT_P1_ITEMS, (int)blockIdx.x - 208, 48); bg.drain();
        }
    }
    SEAM(1);
    if (IN(2)) {
        LAS float* cl = (LAS float*)(lds + att::C_OFF);
        LAS float* wtot = (LAS float*)(lds + att::WSF_OFF);
        cvt_fill_g(F);
        Bg bg; bg.init(F, CVT_P0_ITEMS, CVT_ITEMS - CVT_P0_ITEMS - (F.G == 256 ? CVT_P9_ITEMS + CVT_P4_ITEMS + CVT_P1_ITEMS : 0));
        LAS int* qslot = (LAS int*)(lds + att::WSF_OFF + 2048 + 128);
        int prev_bh = -1;
        const int xq0 = (int)blockIdx.x & 7;
#define Q2_PULL(dst, base, per, total0) do { __syncthreads(); if (F.tid == 0) { int r_ = (total0); \
            unsigned cv_[8]; _Pragma("unroll") for (int a_ = 0; a_ < 8; ++a_) cv_[a_] = __hip_atomic_load(F.ctl + (base) + 16 * ((xq0 + a_) & 7), RLX_AGENT);     \
            _Pragma("unroll") for (int a_ = 0; a_ < 8; ++a_) { if (r_ != (total0) || cv_[a_] >= (unsigned)(per)) continue; const int x_ = (xq0 + a_) & 7; \
                const int v_ = (int)__hip_atomic_fetch_add(F.ctl + (base) + 16 * x_, 1u, RLX_AGENT); if (v_ < (per)) r_ = x_ * (per) + v_; } \
            qslot[0] = r_; } __syncthreads(); dst = __builtin_amdgcn_readfirstlane(qslot[0]); } while (0)
        int item; Q2_PULL(item, CW_Q2, 64, 512);
        while (item < 512) {
            {
            const int bh = item >> 3, j8 = item & 7, b = bh >> 4, h = bh & 15;
            if (bh != prev_bh) {
            { int tidv = F.tid; asm volatile("" : "+v"(tidv)); const int lanev = tidv & 63;
              const float* lf = WSP(float, WS_LOGF) + (size_t)bh * SEQ + tidv * 8;
              const f32x4 a = *(const f32x4*)lf, c4 = *(const f32x4*)(lf + 4);
              float pre[8]; pre[0] = a[0]; pre[1] = pre[0] + a[1]; pre[2] = pre[1] + a[2]; pre[3] = pre[2] + a[3]; pre[4] = pre[3] + c4[0]; pre[5] = pre[4] + c4[1]; pre[6] = pre[5] + c4[2]; pre[7] = pre[6] + c4[3];
              float tot = pre[7], sc = tot;
#pragma unroll
              for (int o = 1; o < 64; o <<= 1) { const int src = lanev >= o ? lanev - o : lanev; const float t = __builtin_bit_cast(float, __builtin_amdgcn_ds_bpermute(src << 2, __builtin_bit_cast(int, sc))); if (lanev >= o) sc += t; }
              __syncthreads();
              if (lanev == 63) wtot[F.wave] = sc;
              __syncthreads();
              float woff = 0.f;
              for (int w = 0; w < F.wave; ++w) woff += wtot[w];
              const float base = woff + sc - tot;
#pragma unroll
              for (int j = 0; j < 8; ++j) cl[tidv * 8 + j] = base + pre[j];
              __syncthreads(); }
            prev_bh = bh; }
            const float kmA = sqrtf(__uint_as_float(F.ctl[CW_KMAX + bh * 2])), kmB = sqrtf(__uint_as_float(F.ctl[CW_KMAX + bh * 2 + 1]));
            for (int i = 0; i < 2; ++i) {
                const int qt = (i == 0) ? 15 - j8 : j8;
                att::Prm P;
                P.Q = WSP(bf16_t, WS_FQ) + (size_t)(b * SEQ + qt * 256) * 1024 + h * 64; P.qp = 1024;
                P.K = WSP(bf16_t, WS_FK) + (size_t)(b * SEQ) * 1024 + h * 64; P.kp = 1024;
                P.V = WSP(bf16_t, WS_FV) + (size_t)(b * SEQ) * 1024 + h * 64; P.vp = 1024;
                P.O = (bf16_t*)(WSP(unsigned char, WS_AO) + (size_t)(b * SEQ + qt * 256) * DM + h * 64); P.op = DM;
                P.q0 = qt * 256; P.kt0 = 0; P.kt1 = 4 * (qt + 1); P.nkeys = SEQ; P.window = 1 << 30; P.c = cl; P.cpos0 = 0; P.sink2 = 0.f;
                P.kmaxA = kmA; P.kmaxB = kmB;
                att::attn_unit<64, true, true, false, true, true>(P, lds, bg);
            }
            }
            Q2_PULL(item, CW_Q2, 64, 512);
        }
        Q2_PULL(item, CW_Q2 + 128, 128, 1024);
        while (item < 1024) {
            {
            const int v = item >> 2;
            const int b = v >> 6, kvh = (v >> 4) & 3, qt = v & 15;
            for (int g = item & 3; g < 4; g += 4) {
                const int hq = kvh * 4 + g;
                const float slope2 = exp2f(-0.5f * (float)(hq + 1)) * LOG2E;
                __syncthreads();
                for (int i = F.tid; i < 384; i += NTHREADS) cl[i] = -slope2 * (float)(i - 128);
                __syncthreads();
                att::Prm P;
                P.Q = WSP(bf16_t, WS_SQ) + (size_t)(b * SEQ + qt * 256) * 1024 + hq * 64; P.qp = 1024;
                P.K = WSP(bf16_t, WS_SK) + (size_t)(b * SEQ) * 256 + kvh * 64; P.kp = 256;
                P.V = WSP(bf16_t, WS_SV) + (size_t)(b * SEQ) * 256 + kvh * 64; P.vp = 256;
                P.O = (bf16_t*)(WSP(unsigned char, WS_AO) + (size_t)(b * SEQ + qt * 256) * DM + 1024 + hq * 64); P.op = DM;
                P.q0 = qt * 256; P.kt0 = qt * 4 - 2; P.kt1 = qt * 4 + 4; P.nkeys = SEQ; P.window = WINDOW; P.c = cl; P.cpos0 = qt * 256 - 128; P.sink2 = F.sinks[hq] * LOG2E; P.kmaxA = 0.f; P.kmaxB = 0.f;
                if (P.kt0 < 0) P.kt0 = 0;
                att::attn_unit<64, true, true, true, false, true>(P, lds, bg);
            }
            }
            Q2_PULL(item, CW_Q2 + 128, 128, 1024);
        }
#undef Q2_PULL
        bg.drain();
    }
    SEAM(2);
    if (IN(3)) {
        SchedGrid S{F.G, (int)blockIdx.x, 64, 8, DM / 2, (const char*)WSP(unsigned char, WS_AO), (const char*)WSP(unsigned char, WS_WOUT)};
        EpiRes E{nullptr, WSP(bf16_t, WS_XB), nullptr, WSP(bf16_t, WS_X1B), (float*)(F.ctl + CW_SSQ1), nullptr, WSCALE_INV};
        pg8::gemm_phase<EpiRes, SchedGrid, true, true, true>(lds, DM / 2, S, E);
    }
    SEAM(3);
    if (IN(4)) {
        SchedGrid S{F.G, (int)blockIdx.x, 64, 2, DM, (const char*)WSP(bf16_t, WS_X1B), (const char*)WSP(bf16_t, WS_WCQ)};
        EpiCQ E{WSP(bf16_t, WS_CQ), (const float*)(F.ctl + CW_SSQ1)};
        pg8::gemm_phase<EpiCQ, SchedGrid, true, true>(lds, DM, S, E);
        if (F.G == 256 && blockIdx.x >= 128) {
            cvt_fill_g(F);
            Bg bg; bg.init(F, CVT_ITEMS - CVT_P9_ITEMS - CVT_P4_ITEMS, CVT_P4_ITEMS, (int)blockIdx.x - 128, 128); bg.drain();
        }
        for (int i = 0; ; ++i) {
            pg8::Unit u; if (!S.next(i, u)) break;
            asm volatile("s_waitcnt vmcnt(0)" ::: "memory"); __syncthreads();
            const int b = u.pm >> 4, qt = u.pm & 15;
            for (int hh = 0; hh < 2; ++hh) { const int h = 2 * u.pn + hh;
                att::Prm P;
                P.Q = WSP(bf16_t, WS_CQ) + (size_t)(b * SEQ + qt * 256) * CW + h * CHD; P.qp = CW;
                P.K = WSP(bf16_t, WS_CKV) + (size_t)(b * NMEM) * 2 * CW + h * CHD; P.kp = 2 * CW;
                P.V = WSP(bf16_t, WS_CKV) + (size_t)(b * NMEM) * 2 * CW + CW + h * CHD; P.vp = 2 * CW;
                P.O = WSP(bf16_t, WS_CO) + (size_t)(b * SEQ + qt * 256) * CW + h * CHD; P.op = CW;
                P.q0 = 0; P.kt0 = 0; P.kt1 = NMEM / 64; P.nkeys = NMEM; P.window = 1 << 30; P.c = nullptr; P.cpos0 = 0; P.sink2 = 0.f; P.kmaxA = 0.f; P.kmaxB = 0.f;
                att::NoBg nobg; att::attn_unit<128, false, false, false, false, false>(P, lds, nobg); }
        }
    }
    SEAM(4);
    if (IN(6)) {
        SchedGrid S{F.G, (int)blockIdx.x, 64, 8, CW, (const char*)WSP(bf16_t, WS_CO), (const char*)WSP(bf16_t, WS_WCO)};
        EpiRes E{nullptr, WSP(bf16_t, WS_X1B), nullptr, WSP(bf16_t, WS_X2), (float*)(F.ctl + CW_SSQ2), WSP(unsigned, WS_X2B), 1.0f};
        pg8::gemm_phase<EpiRes, SchedGrid, true, true>(lds, CW, S, E);
    }
    SEAM(6);
    if (IN(7)) {
        const bf16_t* X2 = WSP(bf16_t, WS_X2); const u32x4* wrb = WSP(u32x4, WS_WRG);
        LAS float* part = (LAS float*)lds; LAS int* hist = (LAS int*)(lds + 34816); LAS int* basel = (LAS int*)(lds + 34816 + 128);
        for (int unit = F.vcu; unit < NTOK / 64; unit += F.G) {
            const int t0 = unit * 64, tg = F.wave & 1, kq = F.wave >> 1, kh = F.lane >> 5, e = F.lane & 31;
            const bf16_t* xg = X2 + (size_t)(t0 + 32 * tg + e) * DM + kq * 512 + 32 * kh;
            const u32x4* wp = wrb + (size_t)(kq * 8) * 512 + F.lane;
            f32x16 acc = f32x16{};
            u32x4 nx[4], nw[8];
#pragma unroll
            for (int j = 0; j < 4; ++j) nx[j] = *(const u32x4*)(xg + 8 * j);
#pragma unroll
            for (int q = 0; q < 8; ++q) nw[q] = wp[q * 64];
            for (int ch = 0; ch < 8; ++ch) {
                u32x4 cx[4], cw[8];
#pragma unroll
                for (int j = 0; j < 4; ++j) cx[j] = nx[j];
#pragma unroll
                for (int q = 0; q < 8; ++q) cw[q] = nw[q];
                if (ch + 1 < 8) {
#pragma unroll
                    for (int j = 0; j < 4; ++j) nx[j] = *(const u32x4*)(xg + (ch + 1) * 64 + 8 * j);
#pragma unroll
                    for (int q = 0; q < 8; ++q) nw[q] = wp[(size_t)(ch + 1) * 512 + q * 64]; }
#pragma unroll
                for (int j = 0; j < 4; ++j) {
                    acc = __builtin_amdgcn_mfma_f32_32x32x16_bf16(__builtin_bit_cast(bf16x8, cx[j]), __builtin_bit_cast(bf16x8, cw[2 * j]), acc, 0, 0, 0);
                    acc = __builtin_amdgcn_mfma_f32_32x32x16_bf16(__builtin_bit_cast(bf16x8, cx[j]), __builtin_bit_cast(bf16x8, cw[2 * j + 1]), acc, 0, 0, 0);
                }
            }
            if (F.tid < 32) hist[F.tid] = 0;
#pragma unroll
            for (int r = 0; r < 16; ++r) part[(kq * 64 + 32 * tg + att::crow(r, kh)) * 33 + e] = acc[r];
            __syncthreads();
            if (F.wave == 0) {
                const int t = t0 + F.lane;
                const float rs = 1.0f / sqrtf(((const float*)(F.ctl + CW_SSQ2))[t] * (1.0f / DM) + RMS_EPS);
                float lg[32];
#pragma unroll
                for (int j = 0; j < 32; ++j) lg[j] = rs * ((part[(0 * 64 + F.lane) * 33 + j] + part[(1 * 64 + F.lane) * 33 + j]) + (part[(2 * 64 + F.lane) * 33 + j] + part[(3 * 64 + F.lane) * 33 + j])) + F.b_router[j];
                float tv[4]; int ti[4];
#pragma unroll
                for (int k = 0; k < 4; ++k) { float best = -INFINITY; int bi = 0;
#pragma unroll
                    for (int j = 0; j < 32; ++j) if (lg[j] > best) { best = lg[j]; bi = j; }
#pragma unroll
                    for (int j = 0; j < 32; ++j) if (j == bi) lg[j] = -INFINITY;
                    tv[k] = best; ti[k] = bi; }
                float ge[4], gs = 0.f;
#pragma unroll
                for (int k = 0; k < 4; ++k) { ge[k] = __expf(tv[k] - tv[0]); gs += ge[k]; }
                const float gi = 1.0f / gs;
                int rk[4];
#pragma unroll
                for (int k = 0; k < 4; ++k) rk[k] = __hip_atomic_fetch_add(&hist[ti[k]], 1, __ATOMIC_RELAXED, __HIP_MEMORY_SCOPE_WORKGROUP);
                LDS_WAIT();
                if (F.lane < 32) { const int hc = hist[F.lane]; int bs = 0; if (hc > 0) bs = (int)__hip_atomic_fetch_add(F.ctl + CW_CNT + F.lane, (unsigned)hc, RLX_AGENT); basel[F.lane] = bs; }
                LDS_WAIT();
                int* rowlist = WSP(int, WS_ROWLIST); float* rowgate = WSP(float, WS_ROWGATE); float* rowrs = WSP(float, WS_ROWRS);
#pragma unroll
                for (int k = 0; k < 4; ++k) { const int pos = basel[ti[k]] + rk[k]; rowlist[ti[k] * ECAP + pos] = t * 4 + k; rowgate[ti[k] * ECAP + pos] = ge[k] * gi; rowrs[ti[k] * ECAP + pos] = rs; }
                WSP(float, WS_RSTD2)[t] = rs;
            }
            __syncthreads();
        }
    }
    SEAM(7);
    if (IN(8)) {
        moe_tables(F, 16);
        const LAS int* tab = (const LAS int*)(lds + TAB_OFF);
        SchedMoe<true> S{tab, F.G, F.vcu, (const char*)WSP(unsigned char, WS_X2B), (const char*)WSP(unsigned char, WS_W1), WSP(int, WS_ROWLIST), (size_t)2 * DE * DM, 0, tab[32]};
        EpiMlp1 E{tab, WSP(int, WS_ROWLIST), WSP(float, WS_ROWRS), F.b_mlp1, WSP(unsigned char, WS_H)};
        pg8::gemm_phase<EpiMlp1, SchedMoe<true>, true, true, true>(lds, DM / 2, S, E);
    }
    SEAM(8);
    if (IN(9)) {
        moe_tables(F, 8);
        const LAS int* tab = (const LAS int*)(lds + TAB_OFF);
        SchedMoe<false> S{tab, F.G, F.vcu, (const char*)WSP(unsigned char, WS_H), (const char*)WSP(unsigned char, WS_W2), WSP(int, WS_ROWLIST), (size_t)DM * DE, 0, tab[32]};
        EpiMlp2 E{tab, WSP(int, WS_ROWLIST), WSP(float, WS_ROWGATE), F.b_mlp2, WSP(unsigned char, WS_Y)};
        const int total = tab[32], split = tab[CVT_P9_E0];
        int nparts = 1, nconv = 0;
        if (F.G == 256) {
            const int rem = total & 255; int first = rem; nconv = 256 - rem;
            if (nconv < 64) { first = 0; nconv = 256; }
            nparts = 2;
            if (F.vcu >= first) {
                Bg bg; bg.init(F, CVT_ITEMS - CVT_P9_ITEMS, CVT_P9_ITEMS, F.vcu - first, nconv); bg.drain();
                VM_WAIT(); __syncthreads();
                if (F.tid == 0) { __builtin_amdgcn_fence(__ATOMIC_RELEASE, "agent"); VM_WAIT(); (void)xb_add((unsigned*)(F.ctl + CW_CVT9), 1u); }
            }
        }
        for (int part = 0; part < nparts; ++part) {
            if (nparts == 2) {
                if (part == 0) { S.i0 = 0; S.Lend = split; }
                else {
                    if (F.tid == 0) { unsigned* bw = (unsigned*)(F.ctl + CW_BAR); XB_SPIN(xb_ld((unsigned*)(F.ctl + CW_CVT9)) < (unsigned)nconv, bw); __builtin_amdgcn_fence(__ATOMIC_ACQUIRE, "agent"); VM_WAIT(); }
                    __syncthreads();
                    S.i0 = F.vcu < split ? (split - F.vcu + F.G - 1) / F.G : 0; S.Lend = total;
                }
            }
            pg8::gemm_phase<EpiMlp2, SchedMoe<false>, true, true, true>(lds, DE / 2, S, E);
        }
    }
    SEAM(9);
    if (IN(10)) {
        const int gw = F.vcu * NWAVES + F.wave, NGW = F.G * NWAVES;
        const bf16_t* X2 = WSP(bf16_t, WS_X2); const unsigned char* Y = WSP(unsigned char, WS_Y);
        f32x4 gfin[4][2];
#pragma unroll
        for (int j = 0; j < 4; ++j)
#pragma unroll
            for (int h = 0; h < 2; ++h) gfin[j][h] = *(const f32x4*)(F.g_final + 8 * F.lane + 512 * j + 4 * h);
        for (int m = gw; m < NTOK; m += NGW) {
            const bf16_t* xr = X2 + (size_t)m * DM + 8 * F.lane;
            f32x4 v[4][2]; float s = 0.f; u32x4 xw[4];
#pragma unroll
            for (int j = 0; j < 4; ++j) xw[j] = *(const u32x4*)(xr + 512 * j);
            u32x2 yw[4][4];
#pragma unroll
            for (int k = 0; k < 4; ++k)
#pragma unroll
                for (int j = 0; j < 4; ++j) yw[k][j] = *(const u32x2*)(Y + (size_t)(m * 4 + k) * DM + 8 * F.lane + 512 * j);
#pragma unroll
            for (int j = 0; j < 4; ++j) { v[j][0] = (f32x4){bf_lo(xw[j].x), bf_hi(xw[j].x), bf_lo(xw[j].y), bf_hi(xw[j].y)}; v[j][1] = (f32x4){bf_lo(xw[j].z), bf_hi(xw[j].z), bf_lo(xw[j].w), bf_hi(xw[j].w)}; }
#pragma unroll
            for (int k = 0; k < 4; ++k)
#pragma unroll
                for (int j = 0; j < 4; ++j) { const f32x2 a = __builtin_amdgcn_cvt_pk_f32_fp8((int)yw[k][j].x, false), b2 = __builtin_amdgcn_cvt_pk_f32_fp8((int)yw[k][j].x, true),
                        c = __builtin_amdgcn_cvt_pk_f32_fp8((int)yw[k][j].y, false), d = __builtin_amdgcn_cvt_pk_f32_fp8((int)yw[k][j].y, true);
                    v[j][0] += (f32x4){a.x, a.y, b2.x, b2.y}; v[j][1] += (f32x4){c.x, c.y, d.x, d.y}; }
#pragma unroll
            for (int j = 0; j < 4; ++j)
#pragma unroll
                for (int h = 0; h < 2; ++h) s += (v[j][h].x * v[j][h].x + v[j][h].y * v[j][h].y) + (v[j][h].z * v[j][h].z + v[j][h].w * v[j][h].w);
            s = wave_sum(s);
            const float rstd = 1.0f / sqrtf(s * (1.0f / DM) + RMS_EPS);
            float* orow = F.out + (size_t)m * DM + 8 * F.lane;
#pragma unroll
            for (int j = 0; j < 4; ++j)
#pragma unroll
                for (int h = 0; h < 2; ++h) *(f32x4*)(orow + 512 * j + 4 * h) = v[j][h] * rstd * gfin[j][h];
        }
    }
#undef IN
#undef SEAM
}

extern "C" void kernel_launch(void* const* d_in, const int* in_sizes, int n_in, void* d_out, int out_size, void* d_ws, size_t ws_size, hipStream_t stream) {
    static int grid = 0;
    if (grid == 0) {
        if (n_in != 20 || in_sizes[0] != NTOK * DM || out_size != NTOK * DM || ws_size < WS_END) { fprintf(stderr, "kernel_launch: unexpected shapes (n_in %d, in0 %d, out %d, ws %zu)\n", n_in, n_in > 0 ? in_sizes[0] : -1, out_size, ws_size); grid = -1; return; }
        int dev = 0, cus = 0, per_cu = 0;
        if (hipGetDevice(&dev) != hipSuccess || hipDeviceGetAttribute(&cus, hipDeviceAttributeMultiprocessorCount, dev) != hipSuccess) { grid = -1; return; }
        if (hipFuncSetAttribute((const void*)mk_fwd, hipFuncAttributeMaxDynamicSharedMemorySize, LDS_BYTES) != hipSuccess) { fprintf(stderr, "kernel_launch: hipFuncSetAttribute failed\n"); grid = -1; return; }
        if (hipOccupancyMaxActiveBlocksPerMultiprocessor(&per_cu, (const void*)mk_fwd, NTHREADS, LDS_BYTES) != hipSuccess || per_cu < 1) fprintf(stderr, "kernel_launch: occupancy query says %d\n", per_cu);
        (void)hipGetLastError();
        grid = cus;
    }
    if (grid < 0) return;
    if (hipMemsetAsync((char*)d_ws + WS_CTL, 0, CTL_ZERO_BYTES, stream) != hipSuccess) return;
    Args a{};
    for (int i = 0; i < 20; ++i) a.in[i] = (const float*)d_in[i];
    a.out = (float*)d_out; a.ws = (unsigned char*)d_ws;
#if MK_ONE_LAUNCH
    a.ph_lo = 0; a.ph_hi = N_PHASES;
    hipLaunchKernelGGL(mk_fwd, dim3(grid), dim3(NTHREADS), LDS_BYTES, stream, a);
#else
    for (int p = 0; p < N_PHASES; ++p) { a.ph_lo = p; a.ph_hi = p + 1; hipLaunchKernelGGL(mk_fwd, dim3(grid), dim3(NTHREADS), LDS_BYTES, stream, a); }
#endif
    const hipError_t le = hipPeekAtLastError();
    if (le != hipSuccess) fprintf(stderr, "kernel_launch: launch failed: %s\n", hipGetErrorName(le));
}
```

```cpp
#include <hip/hip_runtime.h>
#include <cstdio>
#include <cstdint>

#ifndef MK_ONE_LAUNCH
#define MK_ONE_LAUNCH 1
#endif

#define LAS __attribute__((address_space(3)))
#define GAS __attribute__((address_space(1)))
typedef unsigned short bf16_t;
typedef short bf16x8 __attribute__((ext_vector_type(8)));
typedef short s16x4 __attribute__((ext_vector_type(4)));
typedef float f32x4 __attribute__((ext_vector_type(4)));
typedef float f32x2 __attribute__((ext_vector_type(2)));
typedef float f32x16 __attribute__((ext_vector_type(16)));
typedef unsigned u32x4 __attribute__((ext_vector_type(4)));
typedef unsigned u32x2 __attribute__((ext_vector_type(2)));
typedef int i32x4 __attribute__((ext_vector_type(4)));
typedef int i32x8 __attribute__((ext_vector_type(8)));

constexpr int DM = 2048, NBATCH = 4, SEQ = 4096, NTOK = NBATCH * SEQ;
constexpr int HD = 64, NFOX = 16, NSWA = 16, NSKV = 4, WINDOW = 128;
constexpr int NMEM = 256, NCH = 4, CHD = 128, CW = NCH * CHD;
constexpr int NE = 32, TOPK = 4, DE = 2048;
constexpr int IN_COLS = 4624, INP = 4864;
constexpr float RMS_EPS = 1e-5f;
constexpr float LOG2E = 1.4426950408889634f;
constexpr float C2_64 = 0.125f * LOG2E;
constexpr float C2_128 = 0.08838834764831845f * LOG2E;
constexpr int ECAP = NTOK;
constexpr float WSCALE = 64.0f, WSCALE_INV = 1.0f / 64.0f;

constexpr size_t MiB = 1u << 20;
constexpr size_t WS_CTL = 0, CTL_ZERO_BYTES = 1 * MiB;
constexpr size_t WS_WIN = 2 * MiB, WS_WOUT = 22 * MiB, WS_WCQ = 30 * MiB, WS_WCKV = 32 * MiB, WS_WCO = 36 * MiB, WS_MEMB = 38 * MiB;
constexpr size_t WS_RSTD0 = 42 * MiB, WS_RSTDM = 42 * MiB + 65536, WS_WRG = 42 * MiB + 131072  , WS_LOGF = 43 * MiB, WS_RSTD2 = 44 * MiB;
constexpr size_t WS_ROWLIST = 45 * MiB, WS_ROWGATE = 47 * MiB, WS_CKV = 50 * MiB, WS_ROWRS = 52 * MiB;
constexpr size_t WS_XB = 64 * MiB, WS_FQ = 128 * MiB, WS_FK = 160 * MiB, WS_FV = 192 * MiB, WS_SQ = 224 * MiB, WS_SK = 256 * MiB, WS_SV = 264 * MiB;
constexpr size_t WS_AO = 288 * MiB, WS_X1 = 352 * MiB, WS_X1B = 480 * MiB, WS_CQ = 544 * MiB, WS_CO = 560 * MiB, WS_X2 = 576 * MiB, WS_X2B = 704 * MiB;
constexpr size_t WS_W1 = 768 * MiB, WS_W2 = 1280 * MiB, WS_H = 1536 * MiB, WS_Y = 1824 * MiB, WS_END = 2080 * MiB;
constexpr int CW_TMO = 0, CW_CODE = 1, CW_BAR = 4096, CW_CNT = 8192, CW_KMAX = 8320  , CW_Q2 = 8512  , CW_CVT9 = 12288  , CW_SSQ1 = 16384, CW_SSQ2 = 32768;

constexpr int RING_BYTES = 131072;
constexpr int BG_G_OFF = 49152;
constexpr int BG_OFF = 90112;
constexpr int TAB_OFF = 161792;
constexpr int MISC_OFF = TAB_OFF + 1024;
constexpr int LDS_BYTES = 163840;
constexpr int NWAVES = 8, NTHREADS = 512;

#define RLX_AGENT __ATOMIC_RELAXED, __HIP_MEMORY_SCOPE_AGENT
#define LDS_WAIT() asm volatile("s_waitcnt lgkmcnt(0)" ::: "memory")
#define VM_WAIT() asm volatile("s_waitcnt vmcnt(0)" ::: "memory")
__device__ __forceinline__ unsigned f2bf(float f) { unsigned u = __builtin_bit_cast(unsigned, f); return (u + 0x7fffu + ((u >> 16) & 1u)) >> 16; }
__device__ __forceinline__ unsigned pk2(float lo, float hi) { return f2bf(lo) | (f2bf(hi) << 16); }
__device__ __forceinline__ unsigned cvt_pk_bf16(float lo, float hi) { unsigned r; asm volatile("v_cvt_pk_bf16_f32 %0, %1, %2" : "=v"(r) : "v"(lo), "v"(hi)); return r; }
__device__ __forceinline__ unsigned pk4_fp8(float a, float b, float c, float d) { int w = __builtin_amdgcn_cvt_pk_fp8_f32(a, b, 0, false); w = __builtin_amdgcn_cvt_pk_fp8_f32(c, d, w, true); return (unsigned)w; }
__device__ __forceinline__ float bf_lo(unsigned w) { return __builtin_bit_cast(float, w << 16); }
__device__ __forceinline__ float bf_hi(unsigned w) { return __builtin_bit_cast(float, w & 0xffff0000u); }
__device__ __forceinline__ float wave_sum(float v) {
#pragma unroll
    for (int o = 1; o < 64; o <<= 1) v += __shfl_xor(v, o);
    return v;
}

#define XB_TMO      128
#define XB_XCNT(j)  (256  + 64 * (j))
#define XB_XSUB(j)  (1280 + 64 * (j))
#define XB_XGEN(j)  (2304 + 64 * (j))
#define XB_TOP      3328
#define XB_TOPGEN   3392
#define XCD_BAR_WORDS 3456
#define XB_SPIN_CAP (1u << 18)
__device__ __forceinline__ unsigned xb_ld(unsigned* p)              { return __hip_atomic_load(p, __ATOMIC_RELAXED, __HIP_MEMORY_SCOPE_AGENT); }
__device__ __forceinline__ unsigned xb_add(unsigned* p, unsigned v) { return __hip_atomic_fetch_add(p, v, __ATOMIC_RELAXED, __HIP_MEMORY_SCOPE_AGENT); }
__device__ __forceinline__ unsigned xb_xcc_id() { return (unsigned)__builtin_amdgcn_s_getreg((3 << 11) | 20) & 0xFu; }
#define XB_SPIN(cond, bar) do { unsigned _sp = 0; while (cond) { __builtin_amdgcn_s_sleep(1); \
    if ((++_sp & 255u) == 0u) { if (xb_ld(&(bar)[XB_TMO])) break; if (_sp > XB_SPIN_CAP) { atomicAdd(&(bar)[XB_TMO], 1u); break; } } } } while (0)
struct XcdBarrier { unsigned* bar; unsigned x; volatile LAS unsigned* st; };
__device__ __forceinline__ XcdBarrier xcd_barrier_post(unsigned* bar, volatile LAS unsigned* st) {
    XcdBarrier b; b.bar = bar; b.x = xb_xcc_id(); b.st = st;
    if (threadIdx.x == 0) (void)xb_add(&bar[XB_XCNT(b.x)], 1u);
    return b;
}
__device__ __forceinline__ void xcd_barrier_complete(unsigned* bar, unsigned x, unsigned& nloc, unsigned& nx) {
    const unsigned G = gridDim.x * gridDim.y * gridDim.z;
    unsigned sum, cnt, mine, sp = 0u;
    for (;;) {
        sum = 0u; cnt = 0u; mine = 0u;
#pragma unroll
        for (unsigned j = 0; j < 16; ++j) { const unsigned c = xb_ld(&bar[XB_XCNT(j)]); sum += c; cnt += (c > 0u) ? 1u : 0u; mine = (j == x) ? c : mine; }
        if (sum == G) break;
        __builtin_amdgcn_s_sleep(1);
        if ((++sp & 255u) == 0u) { if (xb_ld(&bar[XB_TMO])) break; if (sp > XB_SPIN_CAP) { atomicAdd(&bar[XB_TMO], 1u); break; } }
    }
    nloc = mine > 0u ? mine : 1u; nx = cnt > 0u ? cnt : 1u;
}
__device__ __forceinline__ void xcd_barrier(const XcdBarrier& b) {
    asm volatile("s_waitcnt vmcnt(0)" ::: "memory");
    __syncthreads();
    if (threadIdx.x == 0) {
        unsigned* bar = b.bar;
        __builtin_amdgcn_s_waitcnt(0);
        unsigned nloc = b.st[0], nx = b.st[1];
        if (nloc == 0u) { xcd_barrier_complete(bar, b.x, nloc, nx); b.st[0] = nloc; b.st[1] = nx; }
        const unsigned old = xb_add(&bar[XB_XSUB(b.x)], 1u);
        const unsigned gen = old / nloc;
        if (old + 1u == (gen + 1u) * nloc) {
            __builtin_amdgcn_fence(__ATOMIC_RELEASE, "agent");
            asm volatile("s_waitcnt vmcnt(0)" ::: "memory");
            const unsigned og = xb_add(&bar[XB_TOP], 1u);
            const unsigned tg = og / nx;
            if (og + 1u == (tg + 1u) * nx) xb_add(&bar[XB_TOPGEN], 1u);
            else XB_SPIN(xb_ld(&bar[XB_TOPGEN]) == tg, bar);
            __builtin_amdgcn_fence(__ATOMIC_ACQUIRE, "agent");
            xb_add(&bar[XB_XGEN(b.x)], 1u);
            asm volatile("s_waitcnt vmcnt(0)" ::: "memory");
        } else {
            XB_SPIN(xb_ld(&bar[XB_XGEN(b.x)]) == gen, bar);
            __builtin_amdgcn_fence(__ATOMIC_ACQUIRE, "agent");
            asm volatile("s_waitcnt vmcnt(0)" ::: "memory");
        }
    }
    __syncthreads();
}

namespace pg8 {
constexpr int BM = 256, BK = 64, HALF = 128, HTB = HALF * BK * 2, STAGE_BYTES = 8 * HTB, NXCD = 8, WGM = 8;
__host__ __device__ __forceinline__ int lds_byte(int r, int c) { const int st = (r >> 4) * 2 + (c >> 5), rr = r & 15, cc = c & 31, ob = rr * 64 + cc * 2; return st * 1024 + (ob ^ (((ob >> 9) & 1) << 5)); }
__host__ __device__ __forceinline__ void stage_rc(int b, int& R, int& C) { const int st = b / 1024, sb = b % 1024, swz = sb ^ (((sb >> 9) & 1) << 5); R = (st >> 1) * 16 + swz / 64; C = (st & 1) * 32 + (swz % 64) / 2; }
__host__ __device__ __forceinline__ int perm32(int rho) { const int n = rho >> 4, i = rho & 15; return 8 * (i >> 2) + 4 * n + (i & 3); }

struct Unit { int pm, pn, e, aux; };

__device__ __forceinline__ bool grid_order(int L, int nM, int nN, int& pm, int& pn) {
    const int nwg = nM * nN; if (L >= nwg) return false;
    int wgid = L; { const int q = nwg / NXCD, r = nwg % NXCD, xcd = wgid % NXCD, off = wgid / NXCD; wgid = (xcd < r ? xcd * (q + 1) : r * (q + 1) + (xcd - r) * q) + off; }
    const int nig = WGM * nN, gid = wgid / nig, fm = gid * WGM, gsz = (nM - fm) < WGM ? (nM - fm) : WGM;
    pm = fm + ((wgid % nig) % gsz); pn = (wgid % nig) / gsz; return true;
}

constexpr int PRE_OFF = 131072;
template <class E, class = void> struct EpiPre { static constexpr int N = 0; };
template <class E> struct EpiPre<E, decltype((void)E::NPRE)> { static constexpr int N = E::NPRE; };
template <class Epi, class Sched, bool ALIGN_EPI, bool SP2, bool FP8 = false>
__device__ __forceinline__ void gemm_phase(LAS unsigned char* lds, const int K, const Sched& S, const Epi& E) {
    const int tid = threadIdx.x, wid = __builtin_amdgcn_readfirstlane(tid >> 6), lane = tid & 63, wr = wid >> 2, wc = wid & 3, fr = lane & 15, fq = lane >> 4;
    const int nt = K / BK;
    unsigned voffB[2];
#pragma unroll
    for (int i = 0; i < 2; ++i) { int R, C; stage_rc(tid * 16 + i * 8192, R, C); const int Rb = Epi::PERM ? ((R & ~31) + perm32(R & 31)) : R;
        voffB[i] = (unsigned)(Rb * K + C) * 2u; }
    const size_t kstep = (size_t)(BK * 2);
    const size_t hstep = (size_t)HALF * K * 2;
    const unsigned ldsw = (unsigned)wid * 1024u;
    const int aoff = lds_byte(wr * 64 + fr, fq * 8), boff = lds_byte(wc * 32 + fr, fq * 8);
#define PG8_SA(b, h) (((b) * 2 + (h)) * HTB)
#define PG8_SB(b, h) ((4 + (b) * 2 + (h)) * HTB)
#define PG8_STAGE(bufoff, gbase, voff) do { _Pragma("unroll") for (int _i = 0; _i < 2; ++_i) \
        __builtin_amdgcn_global_load_lds((const unsigned*)((const char*)(gbase) + (voff)[_i]), (LAS unsigned*)(lds + (bufoff) + ldsw + _i * 8192), 16, 0, 0); } while (0)
#define PG8_LD8(p) __builtin_shufflevector(*(const LAS i32x4*)(p), *(const LAS i32x4*)((p) + 1024), 0, 1, 2, 3, 4, 5, 6, 7)
#define PG8_LDA(dst, b, h) do { if constexpr (FP8) { _Pragma("unroll") for (int m = 0; m < 4; ++m) dst##8[m] = PG8_LD8(lds + PG8_SA(b, h) + aoff + m * 2048); } \
        else { _Pragma("unroll") for (int m = 0; m < 4; ++m) _Pragma("unroll") for (int k = 0; k < 2; ++k) dst[m][k] = *(const LAS bf16x8*)(lds + PG8_SA(b, h) + aoff + m * 2048 + k * 1024); } } while (0)
#define PG8_LDB(dst, b, h) do { if constexpr (FP8) { _Pragma("unroll") for (int n = 0; n < 2; ++n) dst##8[n] = PG8_LD8(lds + PG8_SB(b, h) + boff + n * 2048); } \
        else { _Pragma("unroll") for (int n = 0; n < 2; ++n) _Pragma("unroll") for (int k = 0; k < 2; ++k) dst[n][k] = *(const LAS bf16x8*)(lds + PG8_SB(b, h) + boff + n * 2048 + k * 1024); } } while (0)
#define PG8_MMA(ai, bj, At, Bt) do { __builtin_amdgcn_s_setprio(1); \
        if constexpr (FP8) { _Pragma("unroll") for (int m = 0; m < 4; ++m) _Pragma("unroll") for (int n = 0; n < 2; ++n) \
            asm("v_mfma_f32_16x16x128_f8f6f4 %0, %1, %2, %0" : "+v"(acc[ai][bj][m][n]) : "v"(Bt##8[n]), "v"(At##8[m])); } \
        else { _Pragma("unroll") for (int m = 0; m < 4; ++m) _Pragma("unroll") for (int n = 0; n < 2; ++n) _Pragma("unroll") for (int k = 0; k < 2; ++k) \
            acc[ai][bj][m][n] = __builtin_amdgcn_mfma_f32_16x16x32_bf16(Bt[n][k], At[m][k], acc[ai][bj][m][n], 0, 0, 0); } \
        __builtin_amdgcn_s_setprio(0); } while (0)
#define PG8_WAIT_V(n) asm volatile("s_waitcnt vmcnt(" #n ")" ::: "memory")
#define PG8_WAIT_L(n) asm volatile("s_waitcnt lgkmcnt(" #n ")" ::: "memory")
#define PG8_BAR __builtin_amdgcn_s_barrier()
#define PG8_SCHED __builtin_amdgcn_sched_barrier(0)
#define PG8_AOFF(dst, u) do { int _t = tid; asm volatile("" : "+v"(_t)); _Pragma("unroll") for (int _i = 0; _i < 2; ++_i) { int _R, _C; stage_rc(_t * 16 + _i * 8192, _R, _C); \
        _Pragma("unroll") for (int _h = 0; _h < 2; ++_h) dst[_h][_i] = S.a_off(u, _h * HALF + _R) + (unsigned)_C * 2u; } \
        if (Sched::GATHER) { asm volatile("s_waitcnt vmcnt(0)" ::: "memory"); } } while (0)
#define PG8_ARAW(dst, u) do { int _t = tid; asm volatile("" : "+v"(_t)); _Pragma("unroll") for (int _i = 0; _i < 2; ++_i) { int _R, _C; stage_rc(_t * 16 + _i * 8192, _R, _C); \
        _Pragma("unroll") for (int _h = 0; _h < 2; ++_h) dst[_h][_i] = S.a_raw(u, _h * HALF + _R); } } while (0)
#define PG8_AFIN(dst, raw) do { int _t = tid; asm volatile("" : "+v"(_t)); _Pragma("unroll") for (int _i = 0; _i < 2; ++_i) { int _R, _C; stage_rc(_t * 16 + _i * 8192, _R, _C); \
        _Pragma("unroll") for (int _h = 0; _h < 2; ++_h) dst[_h][_i] = S.a_fin(raw[_h][_i]) + (unsigned)_C * 2u; } } while (0)
    Unit cur, nxt, nn; int ui = 0;
    if (!S.next(0, cur)) return;
    f32x4 acc[2][2][4][2];
#pragma unroll
    for (int a = 0; a < 2; ++a)
#pragma unroll
        for (int b = 0; b < 2; ++b)
#pragma unroll
            for (int m = 0; m < 4; ++m)
#pragma unroll
                for (int n = 0; n < 2; ++n) acc[a][b][m][n] = (f32x4){0.f, 0.f, 0.f, 0.f};
    bf16x8 At[4][2], B0[2][2], B1[2][2]; i32x8 At8[4], B08[2], B18[2];
    unsigned vAc[2][2], vAn[2][2]; int rawN[2][2]; bool g_next = false, g_nn = false;
    if constexpr (Sched::GATHER) {
        g_next = S.next(1, nxt);
        if (g_next) PG8_AOFF(vAn, nxt);
    }
    PG8_AOFF(vAc, cur);
    if constexpr (Sched::GATHER) { if (!g_next) {
#pragma unroll
        for (int h = 0; h < 2; ++h)
#pragma unroll
            for (int i = 0; i < 2; ++i) { vAn[h][i] = vAc[h][i]; } }
#pragma unroll
        for (int h = 0; h < 2; ++h)
#pragma unroll
            for (int i = 0; i < 2; ++i) rawN[h][i] = 0; }
    const char* cA = S.a_base(cur); const char* cB = S.b_base(cur);
    static_assert(SP2, "only the SP2 loop is kept");
    PG8_STAGE(PG8_SB(0, 0), cB, voffB); PG8_STAGE(PG8_SB(0, 1), cB + hstep, voffB); PG8_STAGE(PG8_SA(0, 0), cA, vAc[0]); PG8_STAGE(PG8_SA(0, 1), cA, vAc[1]);
    if (wr == 1) PG8_BAR;
    PG8_WAIT_V(2); PG8_BAR;
    PG8_STAGE(PG8_SB(1, 0), cB + kstep, voffB); PG8_STAGE(PG8_SA(1, 0), cA + kstep, vAc[0]); PG8_STAGE(PG8_SB(1, 1), cB + hstep + kstep, voffB);
    PG8_WAIT_V(6); PG8_BAR;
    for (;;) {
        bool has_next;
        const char* nA = cA; const char* nB = cB;
        if constexpr (Sched::GATHER) {
            has_next = g_next;
            if (has_next) { nA = S.a_base(nxt); nB = S.b_base(nxt); }
            g_nn = has_next && S.next(ui + 2, nn);
            if (g_nn) PG8_ARAW(rawN, nn);
        } else {
            has_next = S.next(ui + 1, nxt);
            if (has_next) { nA = S.a_base(nxt); nB = S.b_base(nxt); PG8_AOFF(vAn, nxt); }
            else {
#pragma unroll
                for (int h = 0; h < 2; ++h)
#pragma unroll
                    for (int i = 0; i < 2; ++i) vAn[h][i] = vAc[h][i];
            }
        }
        if constexpr (EpiPre<Epi>::N > 0) {
            if (wid == 0) {
#pragma unroll
                for (int k = 0; k < EpiPre<Epi>::N; ++k)
                    __builtin_amdgcn_global_load_lds((const unsigned*)(E.pre_src(cur, k) + lane * 16), (LAS unsigned*)(lds + PRE_OFF + (ui & 1) * 4096 + k * 1024), 16, 0, 0);
            }
        }
        for (int t = 0; t < nt; t += 2) {
            const bool last = (t == nt - 2);
            const char* a1 = cA + (size_t)(t + 1) * kstep;
            const char* a2 = last ? nA : cA + (size_t)(t + 2) * kstep; const char* b2 = last ? nB : cB + (size_t)(t + 2) * kstep;
            const char* a3 = a2 + kstep; const char* b3 = b2 + kstep;
            unsigned vX0[2], vX1[2];
#pragma unroll
            for (int i = 0; i < 2; ++i) { vX0[i] = last ? vAn[0][i] : vAc[0][i]; vX1[i] = last ? vAn[1][i] : vAc[1][i]; }
            PG8_LDB(B0, 0, 0); PG8_LDB(B1, 0, 1); PG8_SCHED; PG8_LDA(At, 0, 0); PG8_STAGE(PG8_SA(1, 1), a1, vAc[1]);
            PG8_WAIT_V(8); PG8_WAIT_L(0); PG8_BAR; PG8_MMA(0, 0, At, B0); PG8_MMA(0, 1, At, B1); PG8_BAR; PG8_SCHED;
            PG8_LDA(At, 0, 1); PG8_STAGE(PG8_SB(0, 0), b2, voffB); PG8_STAGE(PG8_SB(0, 1), b2 + hstep, voffB); PG8_STAGE(PG8_SA(0, 0), a2, vX0);
            PG8_WAIT_V(8); PG8_WAIT_L(0); PG8_BAR; PG8_MMA(1, 0, At, B0); PG8_MMA(1, 1, At, B1); PG8_BAR; PG8_SCHED;
            PG8_LDB(B0, 1, 0); PG8_LDB(B1, 1, 1); PG8_SCHED; PG8_LDA(At, 1, 0); PG8_STAGE(PG8_SA(0, 1), a2, vX1);
            PG8_WAIT_V(8); PG8_WAIT_L(0); PG8_BAR; PG8_MMA(0, 0, At, B0); PG8_MMA(0, 1, At, B1); PG8_BAR; PG8_SCHED;
            PG8_LDA(At, 1, 1); PG8_STAGE(PG8_SB(1, 0), b3, voffB); PG8_STAGE(PG8_SB(1, 1), b3 + hstep, voffB); PG8_STAGE(PG8_SA(1, 0), a3, vX0);
            PG8_WAIT_V(8); PG8_WAIT_L(0); PG8_BAR; PG8_MMA(1, 0, At, B0); PG8_MMA(1, 1, At, B1); PG8_BAR; PG8_SCHED;
        }
        if constexpr (ALIGN_EPI) { if (wr == 0) PG8_BAR; }
        if constexpr (FP8) { asm volatile("s_nop 15\n\ts_nop 15" ::: "memory"); }
        if constexpr (EpiPre<Epi>::N > 0) E(acc, cur, wr, wc, fr, fq, lds + PRE_OFF + (ui & 1) * 4096); else E(acc, cur, wr, wc, fr, fq);
        if (!has_next) break;
#pragma unroll
        for (int a = 0; a < 2; ++a)
#pragma unroll
            for (int b = 0; b < 2; ++b)
#pragma unroll
                for (int m = 0; m < 4; ++m)
#pragma unroll
                    for (int n = 0; n < 2; ++n) acc[a][b][m][n] = (f32x4){0.f, 0.f, 0.f, 0.f};
        cur = nxt; cA = nA; cB = nB; ++ui;
#pragma unroll
        for (int h = 0; h < 2; ++h)
#pragma unroll
            for (int i = 0; i < 2; ++i) vAc[h][i] = vAn[h][i];
        if constexpr (Sched::GATHER) {
            if (g_nn) PG8_AFIN(vAn, rawN);
            nxt = nn; g_next = g_nn;
        }
        if constexpr (ALIGN_EPI) { if (wr == 1) PG8_BAR; }
    }
    PG8_WAIT_V(0);
    if constexpr (!ALIGN_EPI) { if (wr == 0) PG8_BAR; }
    PG8_BAR;
#undef PG8_SA
#undef PG8_SB
#undef PG8_STAGE
#undef PG8_LDA
#undef PG8_LDB
#undef PG8_MMA
#undef PG8_LD8
#undef PG8_WAIT_V
#undef PG8_WAIT_L
#undef PG8_BAR
#undef PG8_SCHED
#undef PG8_AOFF
#undef PG8_ARAW
#undef PG8_AFIN
}
}

namespace att {
constexpr int KOFF = 0, VOFF = 32768, WSF_OFF = 65536, C_OFF = 69632, ATT_LDS = C_OFF + 16384;
constexpr float THR = 8.0f;
typedef short v4i16_t __attribute__((ext_vector_type(4)));
__device__ __forceinline__ int crow(int r, int hi) { return (r & 3) + 8 * (r >> 2) + 4 * hi; }
__device__ __forceinline__ float max3f(float a, float b, float c) { return __builtin_fmaxf(__builtin_fmaxf(a, b), c); }
__device__ __forceinline__ unsigned cvtpk(float lo, float hi) { typedef __bf16 bf16x2_t __attribute__((ext_vector_type(2))); f32x2 v = {lo, hi}; bf16x2_t b = __builtin_convertvector(v, bf16x2_t); return __builtin_bit_cast(unsigned, b); }
__device__ __forceinline__ s16x4 vtr(const LAS unsigned char* p) { return __builtin_bit_cast(s16x4, __builtin_amdgcn_ds_read_tr16_b64_v4i16((LAS v4i16_t*)p)); }

struct Prm {
    const bf16_t* Q; int qp;
    const bf16_t* K; int kp;
    const bf16_t* V; int vp;
    bf16_t* O; int op;
    int q0;
    int kt0, kt1;
    int nkeys;
    int window;
    const LAS float* c; int cpos0;
    float sink2;
    float kmaxA, kmaxB;
};

struct NoBg { __device__ __forceinline__ bool inflight() const { return false; } __device__ __forceinline__ void tick() {} __device__ __forceinline__ void issue() {} };
template <int D, bool MASK, bool BIAS, bool SINK, bool REV, bool O8, class BG>
__device__ __forceinline__ void attn_unit(const Prm& P, LAS unsigned char* lds, BG& bg) {
    constexpr int NCHK = D / 8, KSLOT = 64 * D * 2, NDB = D / 32, NKS = D / 16;
    const int tid = threadIdx.x, lane = tid & 63, r32 = lane & 31, hi = lane >> 5; const int wid = __builtin_amdgcn_readfirstlane(tid >> 6);
    LAS float* wsf = (LAS float*)(lds + WSF_OFF) + wid * 64;
    const int qw = P.q0 + wid * 32, qpos = qw + r32;
    auto dma_tile = [&](int t, int s) {
        const int kbase = t * 64;
#pragma unroll
        for (int cc = 0; cc < NCHK / 8; ++cc) {
            const int ch = wid + 8 * cc;
            int row = kbase + lane; row = row < 0 ? 0 : (row >= P.nkeys ? P.nkeys - 1 : row);
            __builtin_amdgcn_global_load_lds((const unsigned*)(P.K + (size_t)row * P.kp + ch * 8), (LAS unsigned*)(lds + KOFF + s * KSLOT + ch * 1024), 16, 0, 0);
            const int dblk = ch >> 2, rg = ch & 3;
            int vrow = kbase + 16 * rg + (lane >> 2); vrow = vrow < 0 ? 0 : (vrow >= P.nkeys ? P.nkeys - 1 : vrow);
            __builtin_amdgcn_global_load_lds((const unsigned*)(P.V + (size_t)vrow * P.vp + dblk * 32 + (lane & 3) * 8), (LAS unsigned*)(lds + VOFF + s * KSLOT + ch * 1024), 16, 0, 0);
        }
    };
    dma_tile(REV ? P.kt1 - 1 : P.kt0, 0);
    bf16x8 qr[NKS];
#pragma unroll
    for (int d0 = 0; d0 < NKS; ++d0) qr[d0] = *(const bf16x8*)(P.Q + (size_t)(wid * 32 + r32) * P.qp + d0 * 16 + hi * 8);
    const float cq = BIAS ? P.c[qpos - P.cpos0] : 0.f;
    float mhat = SINK ? P.sink2 : 0.f, l_reg = (SINK && hi == 0) ? 1.f : 0.f;
    bool first = !SINK;
    f32x16 o[NDB];
#pragma unroll
    for (int d = 0; d < NDB; ++d) o[d] = f32x16{};
    float qbnd = 0.f;
    if (REV) {
        float a = 0.f, b = 0.f;
#pragma unroll
        for (int d0 = 0; d0 < NKS; ++d0)
#pragma unroll
            for (int j = 0; j < 8; ++j) { const float v = __builtin_bit_cast(float, (unsigned)(unsigned short)qr[d0][j] << 16); if (d0 < NKS / 2) a += v * v; else b += v * v; }
        { auto rr = __builtin_amdgcn_permlane32_swap(__float_as_uint(a), __float_as_uint(a), false, false); a = __uint_as_float(rr[0]) + __uint_as_float(rr[1]); }
        { auto rr = __builtin_amdgcn_permlane32_swap(__float_as_uint(b), __float_as_uint(b), false, false); b = __uint_as_float(rr[0]) + __uint_as_float(rr[1]); }
        qbnd = 1.02f * (sqrtf(a) * P.kmaxA + sqrtf(b) * P.kmaxB) + 30.0f + cq;
    }
    LAS int* nflag = (LAS int*)(lds + WSF_OFF + 2048);
    int need_cur = 1, need_nxt = 1;
    const int NT = P.kt1 - P.kt0;
    for (int k = 0; k < NT; ++k) {
        const int t = REV ? P.kt1 - 1 - k : P.kt0 + k;
        const int s = k & 1, kbase = t * 64;
        if (k != 0 && bg.inflight()) asm volatile("s_waitcnt vmcnt(16)" ::: "memory");
        else asm volatile("s_waitcnt vmcnt(0)" ::: "memory");
        __syncthreads();
        bool more = k + 1 < NT;
        if (REV && more && k >= 1) { int any = 0;
#pragma unroll
            for (int w = 0; w < 8; ++w) any |= nflag[((k - 1) & 1) * 8 + w];
            more = any != 0; }
        bg.tick();
        if (more) dma_tile(REV ? t - 1 : t + 1, s ^ 1);
        bg.issue();
        bool compute = true, need_mask = false;
        if (MASK) {
            compute = !(kbase > qw + 31 || kbase + 63 < qw - P.window + 1) && (!REV || need_cur != 0);
            need_mask = (kbase + 63 > qw) || (kbase < qw + 31 - P.window + 1) || (kbase < 0);
        }
        if (compute) {
            const float cinit = cq - mhat;
            f32x16 p0, p1;
#pragma unroll
            for (int r = 0; r < 16; ++r) { p0[r] = cinit; p1[r] = cinit; }
            const LAS unsigned char* ks = lds + KOFF + s * KSLOT + hi * 1024 + r32 * 16;
#pragma unroll
            for (int d0 = 0; d0 < NKS; ++d0) {
                const bf16x8 b0 = *(const LAS bf16x8*)(ks + d0 * 2048), b1 = *(const LAS bf16x8*)(ks + d0 * 2048 + 512);
                p0 = __builtin_amdgcn_mfma_f32_32x32x16_bf16(b0, qr[d0], p0, 0, 0, 0);
                p1 = __builtin_amdgcn_mfma_f32_32x32x16_bf16(b1, qr[d0], p1, 0, 0, 0);
            }
            if (BIAS) {
                const LAS float* cb = P.c + (kbase - P.cpos0) + 4 * hi;
#pragma unroll
                for (int g = 0; g < 4; ++g) {
                    const f32x4 a = *(const LAS f32x4*)(cb + 8 * g), b = *(const LAS f32x4*)(cb + 32 + 8 * g);
#pragma unroll
                    for (int j = 0; j < 4; ++j) { p0[4 * g + j] -= a[j]; p1[4 * g + j] -= b[j]; }
                }
            }
            if (MASK && need_mask) {
                const int dq = qpos - kbase; int lo = dq - P.window + 1; lo = lo > -kbase ? lo : -kbase;
                const int lo2 = lo - 4 * hi, hi2 = dq - 4 * hi;
#pragma unroll
                for (int r = 0; r < 16; ++r) {
                    const int kr = (r & 3) + 8 * (r >> 2);
                    if (!(kr >= lo2 && kr <= hi2)) p0[r] = -INFINITY;
                    if (!(kr + 32 >= lo2 && kr + 32 <= hi2)) p1[r] = -INFINITY;
                }
            }
            float a = max3f(p0[0], p0[1], p1[0]), b = max3f(p0[2], p0[3], p1[1]); a = max3f(a, p1[2], p1[3]);
#pragma unroll
            for (int r = 4; r < 16; r += 4) { a = max3f(a, p0[r], p0[r + 1]); b = max3f(b, p0[r + 2], p0[r + 3]); a = max3f(a, p1[r], p1[r + 1]); b = max3f(b, p1[r + 2], p1[r + 3]); }
            float rm = __builtin_fmaxf(a, b);
            { auto rr = __builtin_amdgcn_permlane32_swap(__float_as_uint(rm), __float_as_uint(rm), false, false); rm = __builtin_fmaxf(__uint_as_float(rr[0]), __uint_as_float(rr[1])); }
            if (first || __any(rm > THR)) {
                float dl = first ? rm : __builtin_fmaxf(rm, 0.f);
                if (!(dl > -1e30f)) dl = 0.f;
                mhat += dl;
#pragma unroll
                for (int r = 0; r < 16; ++r) { p0[r] -= dl; p1[r] -= dl; }
                if (!first) {
                    const float f = __builtin_amdgcn_exp2f(-dl); l_reg *= f;
                    if (hi == 0) wsf[r32] = f;
                    LDS_WAIT();
#pragma unroll
                    for (int g = 0; g < 4; ++g) { const f32x4 fv = *(const LAS f32x4*)(wsf + 8 * g + 4 * hi);
#pragma unroll
                        for (int d = 0; d < NDB; ++d)
#pragma unroll
                            for (int j = 0; j < 4; ++j) o[d][4 * g + j] *= fv[j]; }
                }
                first = false;
            }
            float sacc = 0.f;
#pragma unroll
            for (int r = 0; r < 16; ++r) { p0[r] = __builtin_amdgcn_exp2f(p0[r]); p1[r] = __builtin_amdgcn_exp2f(p1[r]); sacc += p0[r] + p1[r]; }
            l_reg += sacc;
            u32x4 pw[4];
#pragma unroll
            for (int q = 0; q < 4; ++q) { pw[0][q] = cvtpk(p0[2 * q], p0[2 * q + 1]); pw[1][q] = cvtpk(p0[8 + 2 * q], p0[9 + 2 * q]); pw[2][q] = cvtpk(p1[2 * q], p1[2 * q + 1]); pw[3][q] = cvtpk(p1[8 + 2 * q], p1[9 + 2 * q]); }
            const LAS unsigned char* vs = lds + VOFF + s * KSLOT + ((lane >> 4) & 1) * 32 + (lane & 3) * 8 + (4 * hi + ((lane & 15) >> 2)) * 64;
#pragma unroll
            for (int d = 0; d < NDB; ++d)
#pragma unroll
                for (int k4 = 0; k4 < 4; ++k4) {
                    const s16x4 vlo = vtr(vs + d * 4096 + k4 * 1024), vhi = vtr(vs + d * 4096 + k4 * 1024 + 512);
                    const bf16x8 vf = (bf16x8){vlo[0], vlo[1], vlo[2], vlo[3], vhi[0], vhi[1], vhi[2], vhi[3]};
                    o[d] = __builtin_amdgcn_mfma_f32_32x32x16_bf16(__builtin_bit_cast(bf16x8, pw[k4]), vf, o[d], 0, 0, 0);
                }
        }
        if (REV) {
            int nn = 0;
            if (t - 2 >= P.kt0) { const float ck = P.c[64 * (t - 1) - 1 - P.cpos0]; nn = (first || __any(qbnd - ck - mhat >= 0.f)) ? 1 : 0; }
            if (lane == 0) nflag[(k & 1) * 8 + wid] = nn;
            need_cur = need_nxt; need_nxt = nn;
            if (!more) break;
        }
    }
    { auto rr = __builtin_amdgcn_permlane32_swap(__float_as_uint(l_reg), __float_as_uint(l_reg), false, false); l_reg = __uint_as_float(rr[0]) + __uint_as_float(rr[1]); }
    if (hi == 0) wsf[32 + r32] = l_reg;
    LDS_WAIT();
    float rli[16];
#pragma unroll
    for (int g = 0; g < 4; ++g) { const f32x4 lv = *(const LAS f32x4*)(wsf + 32 + 8 * g + 4 * hi);
#pragma unroll
        for (int j = 0; j < 4; ++j) rli[4 * g + j] = __builtin_amdgcn_rcpf(lv[j]); }
    __syncthreads();
    int ln = lane; asm volatile("" : "+v"(ln));
    const int r32e = ln & 31, hie = ln >> 5;
    if constexpr (O8) {
        LAS unsigned char* stg = lds + wid * (32 * D) + (4 * hie) * D + r32e;
#pragma unroll
        for (int r = 0; r < 16; ++r) { const int orow = (r & 3) + 8 * (r >> 2);
#pragma unroll
            for (int d = 0; d < NDB; ++d) { const float v = o[d][r] * rli[r]; stg[orow * D + d * 32] = (unsigned char)(__builtin_amdgcn_cvt_pk_fp8_f32(v, v, 0, false) & 0xff); } }
        LDS_WAIT();
        constexpr int CPR = D / 16, RPI = 64 / CPR;
        const LAS unsigned char* stg2 = lds + wid * (32 * D) + (ln / CPR) * D + (ln % CPR) * 16;
        unsigned char* Ow = (unsigned char*)P.O + (size_t)(wid * 32 + ln / CPR) * P.op + (ln % CPR) * 16;
#pragma unroll
        for (int i = 0; i < 32 / RPI; ++i) { const u32x4 v = *(const LAS u32x4*)(stg2 + i * RPI * D); *(u32x4*)(Ow + (size_t)(i * RPI) * P.op) = v; }
    } else {
    LAS bf16_t* stg = (LAS bf16_t*)(lds + wid * (32 * D * 2)) + (4 * hie) * D + r32e;
#pragma unroll
    for (int r = 0; r < 16; ++r) { const int orow = (r & 3) + 8 * (r >> 2);
#pragma unroll
        for (int d = 0; d < NDB; ++d) stg[orow * D + d * 32] = (bf16_t)f2bf(o[d][r] * rli[r]); }
    LDS_WAIT();
    constexpr int CPR = D / 8, RPI = 64 / CPR;
    const LAS bf16_t* stg2 = (const LAS bf16_t*)(lds + wid * (32 * D * 2)) + (ln / CPR) * D + (ln % CPR) * 8;
    bf16_t* Ow = P.O + (size_t)(wid * 32 + ln / CPR) * P.op + (ln % CPR) * 8;
#pragma unroll
    for (int i = 0; i < 32 / RPI; ++i) { const u32x4 v = *(const LAS u32x4*)(stg2 + i * RPI * D); *(u32x4*)(Ow + (size_t)(i * RPI) * P.op) = v; }
    }
    LDS_WAIT();
    __syncthreads();
}
}

struct Frame {
    LAS unsigned char* lds; volatile LAS unsigned* MISC; unsigned* ctl;
    int tid, lane, wave, vcu, G;
    const float *x, *mem, *g_mix, *w_in, *b_forget, *sinks, *w_out, *g_cross, *g_mem, *w_cq, *w_ckv, *w_co, *g_moe, *w_router, *b_router, *w_mlp1, *b_mlp1, *w_mlp2, *b_mlp2, *g_final;
    float* out; unsigned char* ws;
};
#define WSP(T, off) ((T*)(F.ws + (off)))

template <int MAP> __device__ __forceinline__ int rowmap(int n) {
    if (MAP == 1) return n < 3072 ? n : (n < 3088 ? 4608 + (n - 3072) : n - 16);
    if (MAP == 2) { const int o = n >> 1, bj = n & 1; return 256 * (o >> 7) + 128 * bj + (o & 127); }
    return n;
}
__device__ __forceinline__ int tr_rowmap(int map, int n) { return map == 1 ? (n < 3072 ? n : (n < 3088 ? 4608 + (n - 3072) : n - 16)) : n; }
__device__ __forceinline__ void tr_load(float (&v)[32], const float* W, int ldw, int ncols, int k0, int n0, int lane) {
    int nn = n0 + (lane & 31); nn = nn < ncols ? nn : ncols - 1;
    const float* p = W + (size_t)(k0 + (lane >> 5)) * ldw + nn;
#pragma unroll
    for (int i = 0; i < 32; ++i) v[i] = p[(size_t)(2 * i) * ldw];
}
__device__ __forceinline__ void tr_store(bf16_t* WT, const float* g, int ncols, int K, int map, int k0, int n0, LAS float* scr, int lane) {
    const int c = lane & 7;
    f32x4 g0 = (f32x4){1.f, 1.f, 1.f, 1.f}, g1 = g0;
    if (g) { g0 = *(const f32x4*)(g + k0 + 8 * c); g1 = *(const f32x4*)(g + k0 + 8 * c + 4); }
#pragma unroll
    for (int j = 0; j < 4; ++j) { const int nl = (lane >> 3) + 8 * j, n = n0 + nl; const LAS float* s = scr + (8 * c) * 33 + nl;
        u32x4 o; o.x = pk2(s[0 * 33] * g0[0], s[1 * 33] * g0[1]); o.y = pk2(s[2 * 33] * g0[2], s[3 * 33] * g0[3]); o.z = pk2(s[4 * 33] * g1[0], s[5 * 33] * g1[1]); o.w = pk2(s[6 * 33] * g1[2], s[7 * 33] * g1[3]);
        if (n < ncols) *(u32x4*)(WT + (size_t)tr_rowmap(map, n) * K + k0 + 8 * c) = o; }
}
__device__ __forceinline__ void tr_store_f8(unsigned char* WT, int K, int k0, int n0, LAS float* scr, int lane) {
    const int c = lane & 3;
#pragma unroll
    for (int j = 0; j < 2; ++j) { const int nl = (lane >> 2) + 16 * j; const LAS float* s = scr + (16 * c) * 33 + nl; u32x4 o;
#pragma unroll
        for (int q = 0; q < 4; ++q) o[q] = pk4_fp8(s[(4 * q) * 33] * WSCALE, s[(4 * q + 1) * 33] * WSCALE, s[(4 * q + 2) * 33] * WSCALE, s[(4 * q + 3) * 33] * WSCALE);
        *(u32x4*)(WT + (size_t)(n0 + nl) * K + k0 + 16 * c) = o; }
}
__device__ __forceinline__ void row_to_bf16(const float* xrow, bf16_t* orow, float* rstd_out, int lane) {
    const f32x4* xr = (const f32x4*)xrow + lane;
    f32x4 v[8]; float s = 0.f;
#pragma unroll
    for (int j = 0; j < 8; ++j) { v[j] = xr[64 * j]; s += (v[j].x * v[j].x + v[j].y * v[j].y) + (v[j].z * v[j].z + v[j].w * v[j].w); }
    s = wave_sum(s);
    if (lane == 0) *rstd_out = 1.0f / sqrtf(s * (1.0f / DM) + RMS_EPS);
    u32x2* o8 = (u32x2*)orow + lane;
#pragma unroll
    for (int j = 0; j < 8; ++j) { u32x2 w; w.x = pk2(v[j].x, v[j].y); w.y = pk2(v[j].z, v[j].w); o8[64 * j] = w; }
}
constexpr int CVT_ITEMS1 = NE * 16 * 32, CVT_ITEMS2 = NE * 16 * 16, CVT_ITEMS = CVT_ITEMS1 + CVT_ITEMS2;
constexpr int BG_PACE = 2;
constexpr int CVT_P9_ITEMS = 2048;
constexpr int CVT_P9_E0 = 24;
constexpr int CVT_P4_ITEMS = 6144;
constexpr int CVT_P1_ITEMS = 2048;
constexpr int CVT_P0_ITEMS = 0;
struct CvtBuf { f32x4 v[16]; };
struct CvtDesc { const float* W; unsigned char* WT; int ldw, n0, kb0, k0, map; };
__device__ __forceinline__ CvtDesc cvt_desc(const Frame& F, int item, int sub2, int h) {
    CvtDesc d; int kblk, nblk;
    if (item < CVT_ITEMS1) { const int e = item >> 9, rem = item & 511; kblk = rem >> 5; nblk = rem & 31; d.W = F.w_mlp1 + (size_t)e * DM * 2 * DE; d.ldw = 2 * DE; d.WT = F.ws + WS_W1 + (size_t)e * 2 * DE * DM; d.map = 2; }
    else { const int it = item - CVT_ITEMS1; const int e = it >> 8, rem = it & 255; kblk = rem >> 4; nblk = rem & 15; d.W = F.w_mlp2 + (size_t)e * DE * DM; d.ldw = DM; d.WT = F.ws + WS_W2 + (size_t)e * DM * DE; d.map = 0; }
    d.n0 = nblk * 128; d.kb0 = kblk * 128; d.k0 = d.kb0 + 64 * h + 32 * sub2;
    return d;
}
__device__ __forceinline__ void cvt_load(CvtBuf& b, const CvtDesc& d, int lane) {
    const float* p = d.W + (size_t)(d.k0 + 16 * (lane >> 5)) * d.ldw + d.n0 + 4 * (lane & 31);
#pragma unroll
    for (int i = 0; i < 16; ++i) b.v[i] = __builtin_nontemporal_load((const f32x4*)(p + (size_t)i * d.ldw));
}
__device__ __forceinline__ void cvt_to_lds(const CvtBuf& b, const CvtDesc& d, LAS unsigned char* img, const LAS float* gl, int sub2, int h, int lane) {
    const int hh = lane >> 5, l5 = lane & 31;
    float gs[16];
    const bool use_g = d.map == 2;
#pragma unroll
    for (int q = 0; q < 4; ++q) { const f32x4 gv = *(const LAS f32x4*)(gl + d.k0 + 16 * hh + 4 * q);
#pragma unroll
        for (int j = 0; j < 4; ++j) gs[4 * q + j] = use_g ? gv[j] : WSCALE; }
    const int c8 = 4 * h + 2 * sub2 + hh;
#pragma unroll
    for (int j = 0; j < 4; ++j) { u32x4 o;
#pragma unroll
        for (int q = 0; q < 4; ++q) { const int i = 4 * q; o[q] = pk4_fp8(b.v[i][j] * gs[i], b.v[i + 1][j] * gs[i + 1], b.v[i + 2][j] * gs[i + 2], b.v[i + 3][j] * gs[i + 3]); }
        *(LAS u32x4*)(img + (4 * l5 + j) * 128 + 16 * (c8 ^ (l5 & 7))) = o; }
}
__device__ __forceinline__ void cvt_flush(const CvtDesc& d, LAS unsigned char* img, int h, int lane) {
#pragma unroll 4
    for (int it = 0; it < 8; ++it) { const int r = 64 * h + (lane >> 3) + 8 * it, c = lane & 7;
        const u32x4 o = *(const LAS u32x4*)(img + r * 128 + 16 * (c ^ ((r >> 2) & 7)));
        const int n = d.n0 + r; int row = n; if (d.map == 2) { const int oo = n >> 1, bj = n & 1; row = 256 * (oo >> 7) + 128 * bj + (oo & 127); }
        __builtin_nontemporal_store(o, (u32x4*)(d.WT + (size_t)row * DM + d.kb0 + 16 * c)); }
}
__device__ __forceinline__ void cvt_fill_g(const Frame& F) { LAS float* gl = (LAS float*)(F.lds + BG_G_OFF); for (int i = F.tid; i < DM; i += NTHREADS) gl[i] = F.g_moe[i] * WSCALE; __syncthreads(); }
struct Bg {
    CvtBuf buf; const Frame* F; LAS unsigned char* img; const LAS float* gl; int q, nq, pgw, npg, state, ctr, h, fitem;
    __device__ __forceinline__ void init(const Frame& F_, int first_item, int n_items) { init(F_, first_item, n_items, F_.vcu, F_.G); }
    __device__ __forceinline__ void init(const Frame& F_, int first_item, int n_items, int rank, int nranks) {
        F = &F_; img = F_.lds + BG_OFF + (F_.wave >> 1) * 16384; gl = (const LAS float*)(F_.lds + BG_G_OFF); pgw = first_item + rank * 4 + (F_.wave >> 1); npg = nranks * 4; h = F_.wave & 1;
        const int last = first_item + n_items; const int nit = pgw < last ? (last - pgw + npg - 1) / npg : 0; q = 0; nq = nit * 2; state = 0; ctr = 0; fitem = -1; }
    __device__ __forceinline__ int item_of(int qq) const { return pgw + (qq >> 1) * npg; }
    __device__ __forceinline__ CvtDesc desc(int qq) const { return cvt_desc(*F, item_of(qq), qq & 1, h); }
    __device__ __forceinline__ bool inflight() const { return state == 1; }
    __device__ __forceinline__ void proc() { cvt_to_lds(buf, desc(q), img, gl, q & 1, h, F->lane); if (q & 1) fitem = item_of(q); ++q; }
    __device__ __forceinline__ void flush() { if (fitem >= 0) { cvt_flush(cvt_desc(*F, fitem, 0, h), img, h, F->lane); fitem = -1; } }
    __device__ __forceinline__ void tick() { flush(); if (state == 2) { proc(); state = 0; } else if (state == 1) state = 2; }
    __device__ __forceinline__ void issue() { if (state == 0 && q < nq && ctr <= 0) { cvt_load(buf, desc(q), F->lane); state = 1; ctr = BG_PACE; } --ctr; }
    __device__ __forceinline__ void drain() {
        __syncthreads(); flush(); __syncthreads();
        if (state != 0) { proc(); state = 0; if (fitem >= 0) { __syncthreads(); flush(); __syncthreads(); } }
        if (q >= nq) { __syncthreads(); return; }
        CvtBuf b2;
        cvt_load(buf, desc(q), F->lane);
        while (q < nq) {
            if (q + 1 < nq) cvt_load(b2, desc(q + 1), F->lane);
            cvt_to_lds(buf, desc(q), img, gl, q & 1, h, F->lane); if (q & 1) fitem = item_of(q); ++q;
            if (fitem >= 0) { __syncthreads(); flush(); __syncthreads(); }
            if (q >= nq) break;
            if (q + 1 < nq) cvt_load(buf, desc(q + 1), F->lane);
            cvt_to_lds(b2, desc(q), img, gl, q & 1, h, F->lane); if (q & 1) fitem = item_of(q); ++q;
            if (fitem >= 0) { __syncthreads(); flush(); __syncthreads(); }
        }
    }
};
__device__ __forceinline__ void row2_to_bf16(const float* xrow, bf16_t* orow, float* rstd_out, size_t rowdist, int rdist, int lane) {
    const f32x4* xa = (const f32x4*)xrow + lane; const f32x4* xb = (const f32x4*)(xrow + rowdist) + lane;
    f32x4 va[8], vb[8]; float sa = 0.f, sb = 0.f;
#pragma unroll
    for (int j = 0; j < 8; ++j) { va[j] = xa[64 * j]; vb[j] = xb[64 * j]; }
#pragma unroll
    for (int j = 0; j < 8; ++j) { sa += (va[j].x * va[j].x + va[j].y * va[j].y) + (va[j].z * va[j].z + va[j].w * va[j].w); sb += (vb[j].x * vb[j].x + vb[j].y * vb[j].y) + (vb[j].z * vb[j].z + vb[j].w * vb[j].w); }
    sa = wave_sum(sa); sb = wave_sum(sb);
    if (lane == 0) { rstd_out[0] = 1.0f / sqrtf(sa * (1.0f / DM) + RMS_EPS); rstd_out[rdist] = 1.0f / sqrtf(sb * (1.0f / DM) + RMS_EPS); }
    u32x2* oa = (u32x2*)orow + lane; u32x2* ob = (u32x2*)(orow + rowdist) + lane;
#pragma unroll
    for (int j = 0; j < 8; ++j) { u32x2 w; w.x = pk2(va[j].x, va[j].y); w.y = pk2(va[j].z, va[j].w); oa[64 * j] = w; u32x2 w2; w2.x = pk2(vb[j].x, vb[j].y); w2.y = pk2(vb[j].z, vb[j].w); ob[64 * j] = w2; }
}
__device__ __forceinline__ void p0_prologue(Frame& F) {
    LAS float* scr = (LAS float*)(F.lds + F.wave * 16384);
    const int gw = F.vcu * NWAVES + F.wave, NGW = F.G * NWAVES;
    constexpr int I_IN = 32 * 145, I_OUT = 32 * 64, I_CQ = 32 * 16, I_CKV = 32 * 32, I_CO = 8 * 64;
    constexpr int NSMALL = I_IN + I_OUT + I_CQ + I_CKV + I_CO;
    constexpr int NITEMS = NSMALL;
    bf16_t* WIN = WSP(bf16_t, WS_WIN);
#define TR_LOAD(it_) do { int r_ = (it_); \
        if (r_ < I_IN) tr_load(va, F.w_in, IN_COLS, IN_COLS, 64 * (r_ / 145), 32 * (r_ % 145), F.lane); \
        else if ((r_ -= I_IN) < I_OUT) tr_load(va, F.w_out, DM, DM, 64 * (r_ / 64), 32 * (r_ % 64), F.lane); \
        else if ((r_ -= I_OUT) < I_CQ) tr_load(va, F.w_cq, CW, CW, 64 * (r_ / 16), 32 * (r_ % 16), F.lane); \
        else if ((r_ -= I_CQ) < I_CKV) tr_load(va, F.w_ckv, 2 * CW, 2 * CW, 64 * (r_ / 32), 32 * (r_ % 32), F.lane); \
        else { r_ -= I_CKV; tr_load(va, F.w_co, DM, DM, 64 * (r_ / 64), 32 * (r_ % 64), F.lane); } } while (0)
#define TR_STORE(it_) do { int r_ = (it_); \
        if (r_ < I_IN) tr_store(WIN, F.g_mix, IN_COLS, DM, 1, 64 * (r_ / 145), 32 * (r_ % 145), scr, F.lane); \
        else if ((r_ -= I_IN) < I_OUT) tr_store_f8(WSP(unsigned char, WS_WOUT), DM, 64 * (r_ / 64), 32 * (r_ % 64), scr, F.lane); \
        else if ((r_ -= I_OUT) < I_CQ) tr_store(WSP(bf16_t, WS_WCQ), F.g_cross, CW, DM, 0, 64 * (r_ / 16), 32 * (r_ % 16), scr, F.lane); \
        else if ((r_ -= I_CQ) < I_CKV) tr_store(WSP(bf16_t, WS_WCKV), F.g_mem, 2 * CW, DM, 0, 64 * (r_ / 32), 32 * (r_ % 32), scr, F.lane); \
        else { r_ -= I_CKV; tr_store(WSP(bf16_t, WS_WCO), nullptr, DM, CW, 0, 64 * (r_ / 64), 32 * (r_ % 64), scr, F.lane); } } while (0)
    { float va[32]; int it = gw;
      if (it < NITEMS) TR_LOAD(it);
      while (it < NITEMS) {
#pragma unroll
          for (int i = 0; i < 32; ++i) scr[(2 * i + (F.lane >> 5)) * 33 + (F.lane & 31)] = va[i];
          const int itn = it + NGW;
          if (itn < NITEMS) TR_LOAD(itn);
          LDS_WAIT(); asm volatile("" ::: "memory");
          TR_STORE(it);
          LDS_WAIT(); asm volatile("" ::: "memory");
          it = itn;
      } }
#undef TR_LOAD
#undef TR_STORE
    if (CVT_P0_ITEMS > 0) { __syncthreads(); cvt_fill_g(F); Bg bg; bg.init(F, 0, CVT_P0_ITEMS); bg.drain(); }
    { u32x4* z = (u32x4*)(WIN + (size_t)IN_COLS * DM); const int nz = (INP - IN_COLS) * DM * 2 / 16;
      for (int i = F.vcu * NTHREADS + F.tid; i < nz; i += F.G * NTHREADS) z[i] = (u32x4){0u, 0u, 0u, 0u}; }
    { u32x4* wrb = WSP(u32x4, WS_WRG);
      for (int i = F.vcu * NTHREADS + F.tid; i < 32 * 4 * 2 * 64; i += F.G * NTHREADS) {
          const int ln = i & 63, pc = (i >> 6) & 1, j = (i >> 7) & 3, c = i >> 9;
          const int k0 = 64 * c + 32 * (ln >> 5) + 8 * j, n = ln & 31;
          unsigned hw[8];
#pragma unroll
          for (int t = 0; t < 8; ++t) { const float w = F.w_router[(size_t)(k0 + t) * NE + n] * F.g_moe[k0 + t]; const unsigned hi = f2bf(w); const float rest = w - __builtin_bit_cast(float, hi << 16); hw[t] = pc ? f2bf(rest) : hi; }
          wrb[i] = (u32x4){hw[0] | (hw[1] << 16), hw[2] | (hw[3] << 16), hw[4] | (hw[5] << 16), hw[6] | (hw[7] << 16)}; } }
    for (int m = gw; m < NTOK; m += 2 * NGW) row2_to_bf16(F.x + (size_t)m * DM, WSP(bf16_t, WS_XB) + (size_t)m * DM, WSP(float, WS_RSTD0) + m, (size_t)NGW * DM, NGW, F.lane);
    for (int m = gw; m < NBATCH * NMEM; m += NGW) row_to_bf16(F.mem + (size_t)m * DM, WSP(bf16_t, WS_MEMB) + (size_t)m * DM, WSP(float, WS_RSTDM) + m, F.lane);
}

using pg8::Unit;
struct SchedP1 {
    static constexpr bool GATHER = false;
    int G, c; const char *XB, *MEMB, *WIN, *WCKV;
    __device__ __forceinline__ bool next(int i, Unit& u) const {
        int L = i * G + c;
        if (L < 64 * 19) { pg8::grid_order(L, 64, 19, u.pm, u.pn); u.e = 0; u.aux = 0; return true; }
        L -= 64 * 19; if (L < 16) { u.pm = L >> 2; u.pn = L & 3; u.e = 1; u.aux = 0; return true; }
        return false;
    }
    __device__ __forceinline__ const char* a_base(const Unit& u) const { return u.e ? MEMB : XB; }
    __device__ __forceinline__ unsigned a_off(const Unit& u, int r) const { return (unsigned)(u.pm * 256 + r) * (unsigned)(DM * 2); }
    __device__ __forceinline__ const char* b_base(const Unit& u) const { return (u.e ? WCKV : WIN) + (size_t)u.pn * 256 * DM * 2; }
};
struct SchedGrid {
    static constexpr bool GATHER = false;
    int G, c, nM, nN, K; const char *A, *B;
    __device__ __forceinline__ bool next(int i, Unit& u) const { u.e = 0; u.aux = 0; return pg8::grid_order(i * G + c, nM, nN, u.pm, u.pn); }
    __device__ __forceinline__ const char* a_base(const Unit&) const { return A; }
    __device__ __forceinline__ unsigned a_off(const Unit& u, int r) const { return (unsigned)(u.pm * 256 + r) * (unsigned)(K * 2); }
    __device__ __forceinline__ const char* b_base(const Unit& u) const { return B + (size_t)u.pn * 256 * K * 2; }
};
template <bool MLP1> struct SchedMoe {
    static constexpr bool GATHER = MLP1;
    const LAS int* tab; int G, vcu; const char *A, *W; const int* rowlist; size_t estride; int i0, Lend;
    __device__ __forceinline__ bool next(int i, Unit& u) const {
        const int L = (i0 + i) * G + vcu; if (L >= Lend) return false;
        int e = 0;
#pragma unroll
        for (int st = 16; st >= 1; st >>= 1) if (tab[e + st] <= L) e += st;
        const int rem = L - tab[e], nt = tab[66 + e];
        const int pn = rem / nt, pm = rem - pn * nt;
        u.e = __builtin_amdgcn_readfirstlane(e); u.pn = __builtin_amdgcn_readfirstlane(pn); u.pm = __builtin_amdgcn_readfirstlane(pm);
        u.aux = __builtin_amdgcn_readfirstlane((tab[33 + e] + pm) * 256);
        return true;
    }
    __device__ __forceinline__ int nrows(const Unit& u) const { const int n = tab[98 + u.e] - u.pm * 256; return n < 256 ? n : 256; }
    __device__ __forceinline__ const char* a_base(const Unit&) const { return A; }
    __device__ __forceinline__ unsigned a_off(const Unit& u, int r) const {
        if (MLP1) { int pos = u.pm * 256 + r; const int last = tab[98 + u.e] - 1; pos = pos < last ? pos : last; const int ts = rowlist[u.e * ECAP + pos]; return (unsigned)(ts >> 2) * (unsigned)DM; }
        return (unsigned)(u.aux + r) * (unsigned)DE;
    }
    __device__ __forceinline__ int a_raw(const Unit& u, int r) const { int pos = u.pm * 256 + r; const int last = tab[98 + u.e] - 1; pos = pos < last ? pos : last; return rowlist[u.e * ECAP + pos]; }
    __device__ __forceinline__ unsigned a_fin(int ts) const { return (unsigned)(ts >> 2) * (unsigned)DM; }
    __device__ __forceinline__ const char* b_base(const Unit& u) const { return W + (size_t)u.e * estride + (size_t)u.pn * 256 * DM; }
};

typedef const f32x4 (&AccRef)[2][2][4][2];
struct EpiP1 {
    static constexpr bool PERM = true;
    bf16_t *FQ, *FK, *FV, *SQ, *SK, *SV, *CKV; const float *rstd0, *rstdm, *bforget; float* logf; unsigned* kmax;
    __device__ __forceinline__ void operator()(AccRef acc, const Unit& u, int wr, int wc, int fr, int fq) const {
        if (u.e == 0 && u.pn == 18) {
            if (wc == 0 && fq < 2) {
#pragma unroll
                for (int ai = 0; ai < 2; ++ai)
#pragma unroll
                    for (int m = 0; m < 4; ++m) { const int row = u.pm * 256 + ai * 128 + wr * 64 + m * 16 + fr; const float rs = rstd0[row]; const int b = row >> 12, s = row & 4095;
#pragma unroll
                        for (int n = 0; n < 2; ++n)
#pragma unroll
                            for (int j = 0; j < 4; ++j) { const int head = 8 * fq + 4 * n + j; const float z = rs * acc[ai][0][m][n][j] + bforget[head];
                                const float lf2 = __builtin_fminf(z, 0.f) * LOG2E - __builtin_amdgcn_logf(1.0f + __builtin_amdgcn_exp2f(-fabsf(z) * LOG2E)); logf[(size_t)(b * 16 + head) * SEQ + s] = lf2; } }
            }
            return;
        }
        bf16_t* dst; int ldc, col0; float sc = 1.f; const float* rs = rstd0;
        if (u.e == 1) { dst = CKV; ldc = 2 * CW; col0 = u.pn * 256; rs = rstdm; }
        else if (u.pn < 4) { dst = FQ; ldc = 1024; col0 = u.pn * 256; sc = C2_64; }
        else if (u.pn < 8) { dst = FK; ldc = 1024; col0 = (u.pn - 4) * 256; }
        else if (u.pn < 12) { dst = FV; ldc = 1024; col0 = (u.pn - 8) * 256; }
        else if (u.pn < 16) { dst = SQ; ldc = 1024; col0 = (u.pn - 12) * 256; sc = C2_64; }
        else if (u.pn == 16) { dst = SK; ldc = 256; col0 = 0; }
        else { dst = SV; ldc = 256; col0 = 0; }
        col0 += wc * 32 + 8 * fq;
        const bool is_fk = (u.e == 0 && u.pn >= 4 && u.pn < 8);
        float mx[2] = {0.f, 0.f};
        float rsv[8];
#pragma unroll
        for (int i = 0; i < 8; ++i) rsv[i] = rs[u.pm * 256 + (i >> 2) * 128 + wr * 64 + (i & 3) * 16 + fr];
#pragma unroll
        for (int ai = 0; ai < 2; ++ai)
#pragma unroll
            for (int m = 0; m < 4; ++m) { const int row = u.pm * 256 + ai * 128 + wr * 64 + m * 16 + fr; const float f = rsv[ai * 4 + m] * sc; bf16_t* rowp = dst + (size_t)row * ldc + col0;
#pragma unroll
                for (int bj = 0; bj < 2; ++bj) { const f32x4 v0 = acc[ai][bj][m][0] * f, v1 = acc[ai][bj][m][1] * f;
                    u32x4 w; w.x = cvt_pk_bf16(v0[0], v0[1]); w.y = cvt_pk_bf16(v0[2], v0[3]); w.z = cvt_pk_bf16(v1[0], v1[1]); w.w = cvt_pk_bf16(v1[2], v1[3]);
                    *(u32x4*)(rowp + bj * 128) = w;
                    if (is_fk) { float q = (v0[0] * v0[0] + v0[1] * v0[1]) + (v0[2] * v0[2] + v0[3] * v0[3]) + (v1[0] * v1[0] + v1[1] * v1[1]) + (v1[2] * v1[2] + v1[3] * v1[3]);
                        q += __shfl_xor(q, 16); q += __shfl_xor(q, 32); mx[bj] = __builtin_fmaxf(mx[bj], q); } } }
        if (is_fk) {
#pragma unroll
            for (int bj = 0; bj < 2; ++bj) { float q = mx[bj];
#pragma unroll
                for (int o = 1; o < 16; o <<= 1) q = __builtin_fmaxf(q, __shfl_xor(q, o));
                if (fr == 0 && fq == 0) { const int b = (u.pm * 256) >> 12, head = (u.pn - 4) * 4 + 2 * bj + (wc >> 1);
                    __hip_atomic_fetch_max(kmax + (b * 16 + head) * 2 + (wc & 1), __float_as_uint(q), __ATOMIC_RELAXED, __HIP_MEMORY_SCOPE_AGENT); } }
        }
    }
};
struct EpiRes {
    static constexpr bool PERM = true;
    const float* res; const bf16_t* resb; float* outf; bf16_t* outb; float* ssq; unsigned* out8; float ascale;
    __device__ __forceinline__ void operator()(AccRef acc, const Unit& u, int wr, int wc, int fr, int fq) const {
        const int col0 = u.pn * 256 + wc * 32 + 8 * fq;
#pragma unroll
        for (int ai = 0; ai < 2; ++ai) {
            f32x4 rv[4][2][2];
#pragma unroll
            for (int m = 0; m < 4; ++m) { const size_t off = (size_t)(u.pm * 256 + ai * 128 + wr * 64 + m * 16 + fr) * DM + col0;
#pragma unroll
                for (int bj = 0; bj < 2; ++bj) {
                    if (resb) { const u32x4 w = *(const u32x4*)(resb + off + bj * 128);
                        rv[m][bj][0] = (f32x4){bf_lo(w.x), bf_hi(w.x), bf_lo(w.y), bf_hi(w.y)}; rv[m][bj][1] = (f32x4){bf_lo(w.z), bf_hi(w.z), bf_lo(w.w), bf_hi(w.w)}; }
                    else { rv[m][bj][0] = *(const f32x4*)(res + off + bj * 128); rv[m][bj][1] = *(const f32x4*)(res + off + bj * 128 + 4); } } }
#pragma unroll
            for (int m = 0; m < 4; ++m) { const int row = u.pm * 256 + ai * 128 + wr * 64 + m * 16 + fr; const size_t off = (size_t)row * DM + col0; float ss = 0.f;
#pragma unroll
                for (int bj = 0; bj < 2; ++bj) { const size_t o2 = off + bj * 128; const f32x4 v0 = rv[m][bj][0] + acc[ai][bj][m][0] * ascale, v1 = rv[m][bj][1] + acc[ai][bj][m][1] * ascale;
                    if (outf) { *(f32x4*)(outf + o2) = v0; *(f32x4*)(outf + o2 + 4) = v1; }
                    if (outb) { u32x4 w; w.x = cvt_pk_bf16(v0[0], v0[1]); w.y = cvt_pk_bf16(v0[2], v0[3]); w.z = cvt_pk_bf16(v1[0], v1[1]); w.w = cvt_pk_bf16(v1[2], v1[3]); *(u32x4*)(outb + o2) = w; }
                    if (out8) { u32x2 w8; w8.x = pk4_fp8(v0[0], v0[1], v0[2], v0[3]); w8.y = pk4_fp8(v1[0], v1[1], v1[2], v1[3]); *(u32x2*)((unsigned char*)out8 + o2) = w8; }
                    ss += (v0[0] * v0[0] + v0[1] * v0[1]) + (v0[2] * v0[2] + v0[3] * v0[3]) + (v1[0] * v1[0] + v1[1] * v1[1]) + (v1[2] * v1[2] + v1[3] * v1[3]); }
                ss += __shfl_xor(ss, 16); ss += __shfl_xor(ss, 32);
                if (fq == 0) atomicAdd(ssq + row, ss); }
        }
    }
};
struct EpiCQ {
    static constexpr bool PERM = true;
    bf16_t* CQ; const float* ssq1;
    __device__ __forceinline__ void operator()(AccRef acc, const Unit& u, int wr, int wc, int fr, int fq) const {
        const int col0 = u.pn * 256 + wc * 32 + 8 * fq;
        float sq[8];
#pragma unroll
        for (int i = 0; i < 8; ++i) sq[i] = ssq1[u.pm * 256 + (i >> 2) * 128 + wr * 64 + (i & 3) * 16 + fr];
#pragma unroll
        for (int ai = 0; ai < 2; ++ai)
#pragma unroll
            for (int m = 0; m < 4; ++m) { const int row = u.pm * 256 + ai * 128 + wr * 64 + m * 16 + fr; const float f = C2_128 / sqrtf(sq[ai * 4 + m] * (1.0f / DM) + RMS_EPS); bf16_t* rowp = CQ + (size_t)row * CW + col0;
#pragma unroll
                for (int bj = 0; bj < 2; ++bj) { const f32x4 v0 = acc[ai][bj][m][0] * f, v1 = acc[ai][bj][m][1] * f;
                    u32x4 w; w.x = cvt_pk_bf16(v0[0], v0[1]); w.y = cvt_pk_bf16(v0[2], v0[3]); w.z = cvt_pk_bf16(v1[0], v1[1]); w.w = cvt_pk_bf16(v1[2], v1[3]);
                    *(u32x4*)(rowp + bj * 128) = w; } }
    }
};
__device__ __forceinline__ f32x4 swiglu4(f32x4 ug, f32x4 ul) {
    f32x4 xg, xl, e, sg;
#pragma unroll
    for (int j = 0; j < 4; ++j) { xg[j] = __builtin_fminf(ug[j], 7.0f); xl[j] = __builtin_fminf(__builtin_fmaxf(ul[j], -7.0f), 7.0f); }
    const f32x4 t = xg * (-1.702f * LOG2E);
#pragma unroll
    for (int j = 0; j < 4; ++j) e[j] = __builtin_amdgcn_exp2f(t[j]);
    const f32x4 d = e + 1.0f;
#pragma unroll
    for (int j = 0; j < 4; ++j) sg[j] = __builtin_amdgcn_rcpf(d[j]);
    return (xg * sg) * (xl + 1.0f);
}
__device__ __forceinline__ float swiglu1(float ug, float ul) {
    const float xg = __builtin_fminf(ug, 7.0f), xl = __builtin_fminf(__builtin_fmaxf(ul, -7.0f), 7.0f);
    const float sg = __builtin_amdgcn_rcpf(1.0f + __builtin_amdgcn_exp2f(-1.702f * LOG2E * xg));
    return xg * sg * (xl + 1.0f);
}
struct EpiMlp1 {
    static constexpr bool PERM = true;
    const LAS int* tab; const int* rowlist; const float* rowrs; const float* b1; unsigned char* H;
    static constexpr int NPRE = 2;
    __device__ __forceinline__ const char* pre_src(const Unit& u, int k) const {
        return k == 0 ? (const char*)(b1 + (size_t)u.e * 2 * DE + u.pn * 256) : (const char*)(rowrs + (size_t)u.e * ECAP + u.pm * 256); }
    __device__ __forceinline__ void operator()(AccRef acc, const Unit& u, int wr, int wc, int fr, int fq, const LAS unsigned char* pre) const {
        const int o0 = u.pn * 128 + wc * 32 + 8 * fq; const int cnt = tab[98 + u.e];
        f32x4 bb[4];
#pragma unroll
        for (int q = 0; q < 4; ++q) bb[q] = *(const LAS f32x4*)(pre + (2 * (wc * 32 + 8 * fq) + 4 * q) * 4);
        f32x4 bgv[2], blv[2];
#pragma unroll
        for (int n = 0; n < 2; ++n)
#pragma unroll
            for (int j = 0; j < 4; ++j) { const int q = 4 * n + j; bgv[n][j] = bb[q >> 1][(q & 1) * 2]; blv[n][j] = bb[q >> 1][(q & 1) * 2 + 1]; }
        float rsv[8];
#pragma unroll
        for (int i = 0; i < 8; ++i) rsv[i] = *(const LAS float*)(pre + 1024 + ((i >> 2) * 128 + wr * 64 + (i & 3) * 16 + fr) * 4) * WSCALE_INV;
#pragma unroll
        for (int ai = 0; ai < 2; ++ai)
#pragma unroll
            for (int m = 0; m < 4; ++m) { const int r = ai * 128 + wr * 64 + m * 16 + fr, pos = u.pm * 256 + r; const bool valid = pos < cnt;
                const float rs = rsv[ai * 4 + m];
                const f32x4 h0 = swiglu4(acc[ai][0][m][0] * rs + bgv[0], acc[ai][1][m][0] * rs + blv[0]), h1 = swiglu4(acc[ai][0][m][1] * rs + bgv[1], acc[ai][1][m][1] * rs + blv[1]);
                u32x2 w; w.x = pk4_fp8(h0[0], h0[1], h0[2], h0[3]); w.y = pk4_fp8(h1[0], h1[1], h1[2], h1[3]);
                if (valid) *(u32x2*)(H + (size_t)(u.aux + r) * DE + o0) = w; }
    }
};
struct EpiMlp2 {
    static constexpr bool PERM = true;
    const LAS int* tab; const int* rowlist; const float* rowgate; const float* b2; unsigned char* Y;
    static constexpr int NPRE = 3;
    __device__ __forceinline__ const char* pre_src(const Unit& u, int k) const {
        return k == 0 ? (const char*)(b2 + (size_t)u.e * DM + u.pn * 256) : k == 1 ? (const char*)(rowlist + (size_t)u.e * ECAP + u.pm * 256) : (const char*)(rowgate + (size_t)u.e * ECAP + u.pm * 256); }
    __device__ __forceinline__ void operator()(AccRef acc, const Unit& u, int wr, int wc, int fr, int fq, const LAS unsigned char* pre) const {
        const int col0 = u.pn * 256 + wc * 32 + 8 * fq; const int cnt = tab[98 + u.e];
        f32x4 bv[2][2];
#pragma unroll
        for (int bj = 0; bj < 2; ++bj)
#pragma unroll
            for (int n = 0; n < 2; ++n) bv[bj][n] = *(const LAS f32x4*)(pre + (wc * 32 + 8 * fq + bj * 128 + 4 * n) * 4);
        int tsv[8]; float gtv[8];
#pragma unroll
        for (int i = 0; i < 8; ++i) { const int rr = (i >> 2) * 128 + wr * 64 + (i & 3) * 16 + fr; tsv[i] = *(const LAS int*)(pre + 1024 + rr * 4); gtv[i] = *(const LAS float*)(pre + 2048 + rr * 4); }
#pragma unroll
        for (int ai = 0; ai < 2; ++ai)
#pragma unroll
            for (int m = 0; m < 4; ++m) { const int r = ai * 128 + wr * 64 + m * 16 + fr, pos = u.pm * 256 + r; const bool valid = pos < cnt;
                const int ts = tsv[ai * 4 + m]; const float gt = gtv[ai * 4 + m];
                unsigned char* rowp = Y + (size_t)ts * DM + col0;
#pragma unroll
                for (int bj = 0; bj < 2; ++bj) { const f32x4 v0 = (acc[ai][bj][m][0] * WSCALE_INV + bv[bj][0]) * gt, v1 = (acc[ai][bj][m][1] * WSCALE_INV + bv[bj][1]) * gt;
                    u32x2 w; w.x = pk4_fp8(v0[0], v0[1], v0[2], v0[3]); w.y = pk4_fp8(v1[0], v1[1], v1[2], v1[3]);
                    if (valid) *(u32x2*)(rowp + bj * 128) = w; } }
    }
};

__device__ __forceinline__ void moe_tables(Frame& F, int ncol) {
    LAS int* tab = (LAS int*)(F.lds + TAB_OFF);
    if (F.wave == 0) {
        const int e = F.lane & 31;
        const int c = (int)__hip_atomic_load(F.ctl + CW_CNT + e, RLX_AGENT); const int nt = (c + 255) >> 8;
        int inc = nt;
#pragma unroll
        for (int o = 1; o < 32; o <<= 1) { const int t = __shfl_up(inc, o, 32); if (e >= o) inc += t; }
        const int excl = inc - nt;
        if (F.lane < 32) { tab[e] = excl * ncol; tab[33 + e] = excl; tab[66 + e] = nt > 0 ? nt : 1; tab[98 + e] = c;
            if (e == 31) { tab[32] = inc * ncol; tab[65] = inc; } }
    }
    __syncthreads();
}

constexpr int N_PHASES = 11;
struct Args { const float* in[20]; float* out; unsigned char* ws; int ph_lo, ph_hi; };
__global__ void __launch_bounds__(NTHREADS, 2) mk_fwd(Args args) {
    extern __shared__ __attribute__((aligned(16))) unsigned char lds_raw[];
    Frame F;
    F.lds = (LAS unsigned char*)lds_raw; F.MISC = (volatile LAS unsigned*)(F.lds + MISC_OFF);
    F.tid = threadIdx.x; F.lane = F.tid & 63; F.wave = __builtin_amdgcn_readfirstlane(F.tid >> 6);
    F.G = gridDim.x; { const int bx = blockIdx.x; F.vcu = (F.G % 8 == 0) ? (bx % 8) * (F.G / 8) + bx / 8 : bx; }
    F.ws = args.ws; F.ctl = (unsigned*)(args.ws + WS_CTL); F.out = args.out;
    F.x = args.in[0]; F.mem = args.in[1]; F.g_mix = args.in[2]; F.w_in = args.in[3]; F.b_forget = args.in[4]; F.sinks = args.in[5]; F.w_out = args.in[6]; F.g_cross = args.in[7]; F.g_mem = args.in[8];
    F.w_cq = args.in[9]; F.w_ckv = args.in[10]; F.w_co = args.in[11]; F.g_moe = args.in[12]; F.w_router = args.in[13]; F.b_router = args.in[14]; F.w_mlp1 = args.in[15]; F.b_mlp1 = args.in[16];
    F.w_mlp2 = args.in[17]; F.b_mlp2 = args.in[18]; F.g_final = args.in[19];
    for (int u = F.tid; u < (LDS_BYTES - TAB_OFF) / 4; u += NTHREADS) ((LAS unsigned*)(F.lds + TAB_OFF))[u] = 0u;
    __syncthreads();
    const int lo = args.ph_lo, hi = args.ph_hi;
    XcdBarrier bar; bar.bar = (unsigned*)(F.ctl + CW_BAR); bar.x = 0; bar.st = nullptr;
    if (hi - lo > 1) bar = xcd_barrier_post((unsigned*)(F.ctl + CW_BAR), F.MISC + 8);
#define IN(k) (lo <= (k) && (k) < hi)
#define SEAM(k) do { if (IN(k) && IN((k) + 1)) xcd_barrier(bar); } while (0)
    LAS unsigned char* lds = F.lds;

    if (IN(0)) { p0_prologue(F); }
    SEAM(0);
    if (IN(1)) {
        SchedP1 S{F.G, (int)blockIdx.x, (const char*)WSP(bf16_t, WS_XB), (const char*)WSP(bf16_t, WS_MEMB), (const char*)WSP(bf16_t, WS_WIN), (const char*)WSP(bf16_t, WS_WCKV)};
        EpiP1 E{WSP(bf16_t, WS_FQ), WSP(bf16_t, WS_FK), WSP(bf16_t, WS_FV), WSP(bf16_t, WS_SQ), WSP(bf16_t, WS_SK), WSP(bf16_t, WS_SV), WSP(bf16_t, WS_CKV), WSP(float, WS_RSTD0), WSP(float, WS_RSTDM), F.b_forget, WSP(float, WS_LOGF), F.ctl + CW_KMAX};
        pg8::gemm_phase<EpiP1, SchedP1, true, true>(lds, DM, S, E);
        if (F.G == 256 && blockIdx.x >= 208) {
            cvt_fill_g(F);
            Bg bg; bg.init(F, CVT_ITEMS - CVT_P9_ITEMS - CVT_P4_ITEMS - CVT_P1_ITEMS, CVT_P1_ITEMS, (int)blockIdx.x - 208, 48); bg.drain();
        }
    }
    SEAM(1);
    if (IN(2)) {
        LAS float* cl = (LAS float*)(lds + att::C_OFF);
        LAS float* wtot = (LAS float*)(lds + att::WSF_OFF);
        cvt_fill_g(F);
        Bg bg; bg.init(F, CVT_P0_ITEMS, CVT_ITEMS - CVT_P0_ITEMS - (F.G == 256 ? CVT_P9_ITEMS + CVT_P4_ITEMS + CVT_P1_ITEMS : 0));
        LAS int* qslot = (LAS int*)(lds + att::WSF_OFF + 2048 + 128);
        int prev_bh = -1;
        const int xq0 = (int)blockIdx.x & 7;
#define Q2_PULL(dst, base, per, total0) do { __syncthreads(); if (F.tid == 0) { int r_ = (total0); \
            unsigned cv_[8]; _Pragma("unroll") for (int a_ = 0; a_ < 8; ++a_) cv_[a_] = __hip_atomic_load(F.ctl + (base) + 16 * ((xq0 + a_) & 7), RLX_AGENT);     \
            _Pragma("unroll") for (int a_ = 0; a_ < 8; ++a_) { if (r_ != (total0) || cv_[a_] >= (unsigned)(per)) continue; const int x_ = (xq0 + a_) & 7; \
                const int v_ = (int)__hip_atomic_fetch_add(F.ctl + (base) + 16 * x_, 1u, RLX_AGENT); if (v_ < (per)) r_ = x_ * (per) + v_; } \
            qslot[0] = r_; } __syncthreads(); dst = __builtin_amdgcn_readfirstlane(qslot[0]); } while (0)
        int item; Q2_PULL(item, CW_Q2, 64, 512);
        while (item < 512) {
            {
            const int bh = item >> 3, j8 = item & 7, b = bh >> 4, h = bh & 15;
            if (bh != prev_bh) {
            { int tidv = F.tid; asm volatile("" : "+v"(tidv)); const int lanev = tidv & 63;
              const float* lf = WSP(float, WS_LOGF) + (size_t)bh * SEQ + tidv * 8;
              const f32x4 a = *(const f32x4*)lf, c4 = *(const f32x4*)(lf + 4);
              float pre[8]; pre[0] = a[0]; pre[1] = pre[0] + a[1]; pre[2] = pre[1] + a[2]; pre[3] = pre[2] + a[3]; pre[4] = pre[3] + c4[0]; pre[5] = pre[4] + c4[1]; pre[6] = pre[5] + c4[2]; pre[7] = pre[6] + c4[3];
              float tot = pre[7], sc = tot;
#pragma unroll
              for (int o = 1; o < 64; o <<= 1) { const int src = lanev >= o ? lanev - o : lanev; const float t = __builtin_bit_cast(float, __builtin_amdgcn_ds_bpermute(src << 2, __builtin_bit_cast(int, sc))); if (lanev >= o) sc += t; }
              __syncthreads();
              if (lanev == 63) wtot[F.wave] = sc;
              __syncthreads();
              float woff = 0.f;
              for (int w = 0; w < F.wave; ++w) woff += wtot[w];
              const float base = woff + sc - tot;
#pragma unroll
              for (int j = 0; j < 8; ++j) cl[tidv * 8 + j] = base + pre[j];
              __syncthreads(); }
            prev_bh = bh; }
            const float kmA = sqrtf(__uint_as_float(F.ctl[CW_KMAX + bh * 2])), kmB = sqrtf(__uint_as_float(F.ctl[CW_KMAX + bh * 2 + 1]));
            for (int i = 0; i < 2; ++i) {
                const int qt = (i == 0) ? 15 - j8 : j8;
                att::Prm P;
                P.Q = WSP(bf16_t, WS_FQ) + (size_t)(b * SEQ + qt * 256) * 1024 + h * 64; P.qp = 1024;
                P.K = WSP(bf16_t, WS_FK) + (size_t)(b * SEQ) * 1024 + h * 64; P.kp = 1024;
                P.V = WSP(bf16_t, WS_FV) + (size_t)(b * SEQ) * 1024 + h * 64; P.vp = 1024;
                P.O = (bf16_t*)(WSP(unsigned char, WS_AO) + (size_t)(b * SEQ + qt * 256) * DM + h * 64); P.op = DM;
                P.q0 = qt * 256; P.kt0 = 0; P.kt1 = 4 * (qt + 1); P.nkeys = SEQ; P.window = 1 << 30; P.c = cl; P.cpos0 = 0; P.sink2 = 0.f;
                P.kmaxA = kmA; P.kmaxB = kmB;
                att::attn_unit<64, true, true, false, true, true>(P, lds, bg);
            }
            }
            Q2_PULL(item, CW_Q2, 64, 512);
        }
        Q2_PULL(item, CW_Q2 + 128, 128, 1024);
        while (item < 1024) {
            {
            const int v = item >> 2;
            const int b = v >> 6, kvh = (v >> 4) & 3, qt = v & 15;
            for (int g = item & 3; g < 4; g += 4) {
                const int hq = kvh * 4 + g;
                const float slope2 = exp2f(-0.5f * (float)(hq + 1)) * LOG2E;
                __syncthreads();
                for (int i = F.tid; i < 384; i += NTHREADS) cl[i] = -slope2 * (float)(i - 128);
                __syncthreads();
                att::Prm P;
                P.Q = WSP(bf16_t, WS_SQ) + (size_t)(b * SEQ + qt * 256) * 1024 + hq * 64; P.qp = 1024;
                P.K = WSP(bf16_t, WS_SK) + (size_t)(b * SEQ) * 256 + kvh * 64; P.kp = 256;
                P.V = WSP(bf16_t, WS_SV) + (size_t)(b * SEQ) * 256 + kvh * 64; P.vp = 256;
                P.O = (bf16_t*)(WSP(unsigned char, WS_AO) + (size_t)(b * SEQ + qt * 256) * DM + 1024 + hq * 64); P.op = DM;
                P.q0 = qt * 256; P.kt0 = qt * 4 - 2; P.kt1 = qt * 4 + 4; P.nkeys = SEQ; P.window = WINDOW; P.c = cl; P.cpos0 = qt * 256 - 128; P.sink2 = F.sinks[hq] * LOG2E; P.kmaxA = 0.f; P.kmaxB = 0.f;
                if (P.kt0 < 0) P.kt0 = 0;
                att::attn_unit<64, true, true, true, false, true>(P, lds, bg);
            }
            }
            Q2_PULL(item, CW_Q2 + 128, 128, 1024);
        }
#undef Q2_PULL
        bg.drain();
    }
    SEAM(2);
    if (IN(3)) {
        SchedGrid S{F.G, (int)blockIdx.x, 64, 8, DM / 2, (const char*)WSP(unsigned char, WS_AO), (const char*)WSP(unsigned char, WS_WOUT)};
        EpiRes E{nullptr, WSP(bf16_t, WS_XB), nullptr, WSP(bf16_t, WS_X1B), (float*)(F.ctl + CW_SSQ1), nullptr, WSCALE_INV};
        pg8::gemm_phase<EpiRes, SchedGrid, true, true, true>(lds, DM / 2, S, E);
    }
    SEAM(3);
    if (IN(4)) {
        SchedGrid S{F.G, (int)blockIdx.x, 64, 2, DM, (const char*)WSP(bf16_t, WS_X1B), (const char*)WSP(bf16_t, WS_WCQ)};
        EpiCQ E{WSP(bf16_t, WS_CQ), (const float*)(F.ctl + CW_SSQ1)};
        pg8::gemm_phase<EpiCQ, SchedGrid, true, true>(lds, DM, S, E);
        if (F.G == 256 && blockIdx.x >= 128) {
            cvt_fill_g(F);
            Bg bg; bg.init(F, CVT_ITEMS - CVT_P9_ITEMS - CVT_P4_ITEMS, CVT_P4_ITEMS, (int)blockIdx.x - 128, 128); bg.drain();
        }
        for (int i = 0; ; ++i) {
            pg8::Unit u; if (!S.next(i, u)) break;
            asm volatile("s_waitcnt vmcnt(0)" ::: "memory"); __syncthreads();
            const int b = u.pm >> 4, qt = u.pm & 15;
            for (int hh = 0; hh < 2; ++hh) { const int h = 2 * u.pn + hh;
                att::Prm P;
                P.Q = WSP(bf16_t, WS_CQ) + (size_t)(b * SEQ + qt * 256) * CW + h * CHD; P.qp = CW;
                P.K = WSP(bf16_t, WS_CKV) + (size_t)(b * NMEM) * 2 * CW + h * CHD; P.kp = 2 * CW;
                P.V = WSP(bf16_t, WS_CKV) + (size_t)(b * NMEM) * 2 * CW + CW + h * CHD; P.vp = 2 * CW;
                P.O = WSP(bf16_t, WS_CO) + (size_t)(b * SEQ + qt * 256) * CW + h * CHD; P.op = CW;
                P.q0 = 0; P.kt0 = 0; P.kt1 = NMEM / 64; P.nkeys = NMEM; P.window = 1 << 30; P.c = nullptr; P.cpos0 = 0; P.sink2 = 0.f; P.kmaxA = 0.f; P.kmaxB = 0.f;
                att::NoBg nobg; att::attn_unit<128, false, false, false, false, false>(P, lds, nobg); }
        }
    }
    SEAM(4);
    if (IN(6)) {
        SchedGrid S{F.G, (int)blockIdx.x, 64, 8, CW, (const char*)WSP(bf16_t, WS_CO), (const char*)WSP(bf16_t, WS_WCO)};
        EpiRes E{nullptr, WSP(bf16_t, WS_X1B), nullptr, WSP(bf16_t, WS_X2), (float*)(F.ctl + CW_SSQ2), WSP(unsigned, WS_X2B), 1.0f};
        pg8::gemm_phase<EpiRes, SchedGrid, true, true>(lds, CW, S, E);
    }
    SEAM(6);
    if (IN(7)) {
        const bf16_t* X2 = WSP(bf16_t, WS_X2); const u32x4* wrb = WSP(u32x4, WS_WRG);
        LAS float* part = (LAS float*)lds; LAS int* hist = (LAS int*)(lds + 34816); LAS int* basel = (LAS int*)(lds + 34816 + 128);
        for (int unit = F.vcu; unit < NTOK / 64; unit += F.G) {
            const int t0 = unit * 64, tg = F.wave & 1, kq = F.wave >> 1, kh = F.lane >> 5, e = F.lane & 31;
            const bf16_t* xg = X2 + (size_t)(t0 + 32 * tg + e) * DM + kq * 512 + 32 * kh;
            const u32x4* wp = wrb + (size_t)(kq * 8) * 512 + F.lane;
            f32x16 acc = f32x16{};
            u32x4 nx[4], nw[8];
#pragma unroll
            for (int j = 0; j < 4; ++j) nx[j] = *(const u32x4*)(xg + 8 * j);
#pragma unroll
            for (int q = 0; q < 8; ++q) nw[q] = wp[q * 64];
            for (int ch = 0; ch < 8; ++ch) {
                u32x4 cx[4], cw[8];
#pragma unroll
                for (int j = 0; j < 4; ++j) cx[j] = nx[j];
#pragma unroll
                for (int q = 0; q < 8; ++q) cw[q] = nw[q];
                if (ch + 1 < 8) {
#pragma unroll
                    for (int j = 0; j < 4; ++j) nx[j] = *(const u32x4*)(xg + (ch + 1) * 64 + 8 * j);
#pragma unroll
                    for (int q = 0; q < 8; ++q) nw[q] = wp[(size_t)(ch + 1) * 512 + q * 64]; }
#pragma unroll
                for (int j = 0; j < 4; ++j) {
                    acc = __builtin_amdgcn_mfma_f32_32x32x16_bf16(__builtin_bit_cast(bf16x8, cx[j]), __builtin_bit_cast(bf16x8, cw[2 * j]), acc, 0, 0, 0);
                    acc = __builtin_amdgcn_mfma_f32_32x32x16_bf16(__builtin_bit_cast(bf16x8, cx[j]), __builtin_bit_cast(bf16x8, cw[2 * j + 1]), acc, 0, 0, 0);
                }
            }
            if (F.tid < 32) hist[F.tid] = 0;
#pragma unroll
            for (int r = 0; r < 16; ++r) part[(kq * 64 + 32 * tg + att::crow(r, kh)) * 33 + e] = acc[r];
            __syncthreads();
            if (F.wave == 0) {
                const int t = t0 + F.lane;
                const float rs = 1.0f / sqrtf(((const float*)(F.ctl + CW_SSQ2))[t] * (1.0f / DM) + RMS_EPS);
                float lg[32];
#pragma unroll
                for (int j = 0; j < 32; ++j) lg[j] = rs * ((part[(0 * 64 + F.lane) * 33 + j] + part[(1 * 64 + F.lane) * 33 + j]) + (part[(2 * 64 + F.lane) * 33 + j] + part[(3 * 64 + F.lane) * 33 + j])) + F.b_router[j];
                float tv[4]; int ti[4];
#pragma unroll
                for (int k = 0; k < 4; ++k) { float best = -INFINITY; int bi = 0;
#pragma unroll
                    for (int j = 0; j < 32; ++j) if (lg[j] > best) { best = lg[j]; bi = j; }
#pragma unroll
                    for (int j = 0; j < 32; ++j) if (j == bi) lg[j] = -INFINITY;
                    tv[k] = best; ti[k] = bi; }
                float ge[4], gs = 0.f;
#pragma unroll
                for (int k = 0; k < 4; ++k) { ge[k] = __expf(tv[k] - tv[0]); gs += ge[k]; }
                const float gi = 1.0f / gs;
                int rk[4];
#pragma unroll
                for (int k = 0; k < 4; ++k) rk[k] = __hip_atomic_fetch_add(&hist[ti[k]], 1, __ATOMIC_RELAXED, __HIP_MEMORY_SCOPE_WORKGROUP);
                LDS_WAIT();
                if (F.lane < 32) { const int hc = hist[F.lane]; int bs = 0; if (hc > 0) bs = (int)__hip_atomic_fetch_add(F.ctl + CW_CNT + F.lane, (unsigned)hc, RLX_AGENT); basel[F.lane] = bs; }
                LDS_WAIT();
                int* rowlist = WSP(int, WS_ROWLIST); float* rowgate = WSP(float, WS_ROWGATE); float* rowrs = WSP(float, WS_ROWRS);
#pragma unroll
                for (int k = 0; k < 4; ++k) { const int pos = basel[ti[k]] + rk[k]; rowlist[ti[k] * ECAP + pos] = t * 4 + k; rowgate[ti[k] * ECAP + pos] = ge[k] * gi; rowrs[ti[k] * ECAP + pos] = rs; }
                WSP(float, WS_RSTD2)[t] = rs;
            }
            __syncthreads();
        }
    }
    SEAM(7);
    if (IN(8)) {
        moe_tables(F, 16);
        const LAS int* tab = (const LAS int*)(lds + TAB_OFF);
        SchedMoe<true> S{tab, F.G, F.vcu, (const char*)WSP(unsigned char, WS_X2B), (const char*)WSP(unsigned char, WS_W1), WSP(int, WS_ROWLIST), (size_t)2 * DE * DM, 0, tab[32]};
        EpiMlp1 E{tab, WSP(int, WS_ROWLIST), WSP(float, WS_ROWRS), F.b_mlp1, WSP(unsigned char, WS_H)};
        pg8::gemm_phase<EpiMlp1, SchedMoe<true>, true, true, true>(lds, DM / 2, S, E);
    }
    SEAM(8);
    if (IN(9)) {
        moe_tables(F, 8);
        const LAS int* tab = (const LAS int*)(lds + TAB_OFF);
        SchedMoe<false> S{tab, F.G, F.vcu, (const char*)WSP(unsigned char, WS_H), (const char*)WSP(unsigned char, WS_W2), WSP(int, WS_ROWLIST), (size_t)DM * DE, 0, tab[32]};
        EpiMlp2 E{tab, WSP(int, WS_ROWLIST), WSP(float, WS_ROWGATE), F.b_mlp2, WSP(unsigned char, WS_Y)};
        const int total = tab[32], split = tab[CVT_P9_E0];
        int nparts = 1, nconv = 0;
        if (F.G == 256) {
            const int rem = total & 255; int first = rem; nconv = 256 - rem;
            if (nconv < 64) { first = 0; nconv = 256; }
            nparts = 2;
            if (F.vcu >= first) {
                Bg bg; bg.init(F, CVT_ITEMS - CVT_P9_ITEMS, CVT_P9_ITEMS, F.vcu - first, nconv); bg.drain();
                VM_WAIT(); __syncthreads();
                if (F.tid == 0) { __builtin_amdgcn_fence(__ATOMIC_RELEASE, "agent"); VM_WAIT(); (void)xb_add((unsigned*)(F.ctl + CW_CVT9), 1u); }
            }
        }
        for (int part = 0; part < nparts; ++part) {
            if (nparts == 2) {
                if (part == 0) { S.i0 = 0; S.Lend = split; }
                else {
                    if (F.tid == 0) { unsigned* bw = (unsigned*)(F.ctl + CW_BAR); XB_SPIN(xb_ld((unsigned*)(F.ctl + CW_CVT9)) < (unsigned)nconv, bw); __builtin_amdgcn_fence(__ATOMIC_ACQUIRE, "agent"); VM_WAIT(); }
                    __syncthreads();
                    S.i0 = F.vcu < split ? (split - F.vcu + F.G - 1) / F.G : 0; S.Lend = total;
                }
            }
            pg8::gemm_phase<EpiMlp2, SchedMoe<false>, true, true, true>(lds, DE / 2, S, E);
        }
    }
    SEAM(9);
    if (IN(10)) {
        const int gw = F.vcu * NWAVES + F.wave, NGW = F.G * NWAVES;
        const bf16_t* X2 = WSP(bf16_t, WS_X2); const unsigned char* Y = WSP(unsigned char, WS_Y);
        f32x4 gfin[4][2];
#pragma unroll
        for (int j = 0; j < 4; ++j)
#pragma unroll
            for (int h = 0; h < 2; ++h) gfin[j][h] = *(const f32x4*)(F.g_final + 8 * F.lane + 512 * j + 4 * h);
        for (int m = gw; m < NTOK; m += NGW) {
            const bf16_t* xr = X2 + (size_t)m * DM + 8 * F.lane;
            f32x4 v[4][2]; float s = 0.f; u32x4 xw[4];
#pragma unroll
            for (int j = 0; j < 4; ++j) xw[j] = *(const u32x4*)(xr + 512 * j);
            u32x2 yw[4][4];
#pragma unroll
            for (int k = 0; k < 4; ++k)
#pragma unroll
                for (int j = 0; j < 4; ++j) yw[k][j] = *(const u32x2*)(Y + (size_t)(m * 4 + k) * DM + 8 * F.lane + 512 * j);
#pragma unroll
            for (int j = 0; j < 4; ++j) { v[j][0] = (f32x4){bf_lo(xw[j].x), bf_hi(xw[j].x), bf_lo(xw[j].y), bf_hi(xw[j].y)}; v[j][1] = (f32x4){bf_lo(xw[j].z), bf_hi(xw[j].z), bf_lo(xw[j].w), bf_hi(xw[j].w)}; }
#pragma unroll
            for (int k = 0; k < 4; ++k)
#pragma unroll
                for (int j = 0; j < 4; ++j) { const f32x2 a = __builtin_amdgcn_cvt_pk_f32_fp8((int)yw[k][j].x, false), b2 = __builtin_amdgcn_cvt_pk_f32_fp8((int)yw[k][j].x, true),
                        c = __builtin_amdgcn_cvt_pk_f32_fp8((int)yw[k][j].y, false), d = __builtin_amdgcn_cvt_pk_f32_fp8((int)yw[k][j].y, true);
                    v[j][0] += (f32x4){a.x, a.y, b2.x, b2.y}; v[j][1] += (f32x4){c.x, c.y, d.x, d.y}; }
#pragma unroll
            for (int j = 0; j < 4; ++j)
#pragma unroll
                for (int h = 0; h < 2; ++h) s += (v[j][h].x * v[j][h].x + v[j][h].y * v[j][h].y) + (v[j][h].z * v[j][h].z + v[j][h].w * v[j][h].w);
            s = wave_sum(s);
            const float rstd = 1.0f / sqrtf(s * (1.0f / DM) + RMS_EPS);
            float* orow = F.out + (size_t)m * DM + 8 * F.lane;
#pragma unroll
            for (int j = 0; j < 4; ++j)
#pragma unroll
                for (int h = 0; h < 2; ++h) *(f32x4*)(orow + 512 * j + 4 * h) = v[j][h] * rstd * gfin[j][h];
        }
    }
#undef IN
#undef SEAM
}

extern "C" void kernel_launch(void* const* d_in, const int* in_sizes, int n_in, void* d_out, int out_size, void* d_ws, size_t ws_size, hipStream_t stream) {
    static int grid = 0;
    if (grid == 0) {
        if (n_in != 20 || in_sizes[0] != NTOK * DM || out_size != NTOK * DM || ws_size < WS_END) { fprintf(stderr, "kernel_launch: unexpected shapes (n_in %d, in0 %d, out %d, ws %zu)\n", n_in, n_in > 0 ? in_sizes[0] : -1, out_size, ws_size); grid = -1; return; }
        int dev = 0, cus = 0, per_cu = 0;
        if (hipGetDevice(&dev) != hipSuccess || hipDeviceGetAttribute(&cus, hipDeviceAttributeMultiprocessorCount, dev) != hipSuccess) { grid = -1; return; }
        if (hipFuncSetAttribute((const void*)mk_fwd, hipFuncAttributeMaxDynamicSharedMemorySize, LDS_BYTES) != hipSuccess) { fprintf(stderr, "kernel_launch: hipFuncSetAttribute failed\n"); grid = -1; return; }
        if (hipOccupancyMaxActiveBlocksPerMultiprocessor(&per_cu, (const void*)mk_fwd, NTHREADS, LDS_BYTES) != hipSuccess || per_cu < 1) fprintf(stderr, "kernel_launch: occupancy query says %d\n", per_cu);
        (void)hipGetLastError();
        grid = cus;
    }
    if (grid < 0) return;
    if (hipMemsetAsync((char*)d_ws + WS_CTL, 0, CTL_ZERO_BYTES, stream) != hipSuccess) return;
    Args a{};
    for (int i = 0; i < 20; ++i) a.in[i] = (const float*)d_in[i];
    a.out = (float*)d_out; a.ws = (unsigned char*)d_ws;
#if MK_ONE_LAUNCH
    a.ph_lo = 0; a.ph_hi = N_PHASES;
    hipLaunchKernelGGL(mk_fwd, dim3(grid), dim3(NTHREADS), LDS_BYTES, stream, a);
#else
    for (int p = 0; p < N_PHASES; ++p) { a.ph_lo = p; a.ph_hi = p + 1; hipLaunchKernelGGL(mk_fwd, dim3(grid), dim3(NTHREADS), LDS_BYTES, stream, a); }
#endif
    const hipError_t le = hipPeekAtLastError();
    if (le != hipSuccess) fprintf(stderr, "kernel_launch: launch failed: %s\n", hipGetErrorName(le));
}
```
